# Optimizing an MI355X kernel written in HIP

```python
import jax, jax.numpy as jnp
from jax import lax
import numpy as np

D_MODEL = 1024
BATCH = 8
SEQ = 4096
DEPTH = 1

CHUNK = 64
N_LEFT_CHUNKS = 8
BAND = (N_LEFT_CHUNKS + 1) * CHUNK
A_HEADS = 8
A_HEAD_DIM = 64
A_WIDTH = A_HEADS * A_HEAD_DIM
REL_CLIP = 256
B_HEADS = 8
B_HEAD_DIM = 64
B_WIDTH = B_HEADS * B_HEAD_DIM
IDX_HEADS = 8
IDX_DIM = 32
TOPK_MAX = 256
Q_BLOCK = 128
ROPE_THETA = 500000.0
ROT_DIM_B = B_HEAD_DIM // 4
ROT_DIM_IDX = IDX_DIM // 4
EPS = 1e-6
NEG = -1e30

SPLIT_SIZES = (
    A_WIDTH, A_WIDTH, A_WIDTH, A_WIDTH,
    B_WIDTH, B_HEAD_DIM, B_HEAD_DIM, B_WIDTH,
    IDX_HEADS * IDX_DIM, IDX_DIM, IDX_HEADS,
    D_MODEL, D_MODEL,
)
IN_WIDTH = sum(SPLIT_SIZES)

kernel_name = "hybrid_chunked_relpos_dsa_gated_block"


def rms_norm(x, g):
    xf = x.astype(jnp.float32)
    y = xf * lax.rsqrt(jnp.mean(xf * xf, axis=-1, keepdims=True) + EPS)
    return (y * g.astype(jnp.float32)).astype(x.dtype)


def partial_rope(x, rot_dim):
    S = x.shape[1]
    half = rot_dim // 2
    inv = ROPE_THETA ** (-jnp.arange(half, dtype=jnp.float32) / half)
    ang = jnp.arange(S, dtype=jnp.float32)[:, None] * inv[None, :]
    cos = jnp.cos(ang)[None, :, None, :].astype(x.dtype)
    sin = jnp.sin(ang)[None, :, None, :].astype(x.dtype)
    x1, x2, xp = x[..., :half], x[..., half:rot_dim], x[..., rot_dim:]
    return jnp.concatenate([x1 * cos - x2 * sin, x2 * cos + x1 * sin, xp], axis=-1)


def chunked_relpos_attention(q, k, v, rel_bias):
    B, S, H, d = q.shape
    n_chunks = S // CHUNK
    pad = N_LEFT_CHUNKS * CHUNK
    k_pad = jnp.pad(k, ((0, 0), (pad, 0), (0, 0), (0, 0)))
    v_pad = jnp.pad(v, ((0, 0), (pad, 0), (0, 0), (0, 0)))
    i = jnp.arange(CHUNK)[:, None]
    j = jnp.arange(BAND)[None, :]
    dist = pad + i - j
    bias = rel_bias.astype(jnp.float32)[:, jnp.clip(dist, -REL_CLIP, REL_CLIP) + REL_CLIP]
    scale = d ** -0.5

    def one_chunk(c):
        start = c * CHUNK
        qc = lax.dynamic_slice_in_dim(q, start, CHUNK, axis=1)
        kc = lax.dynamic_slice_in_dim(k_pad, start, BAND, axis=1)
        vc = lax.dynamic_slice_in_dim(v_pad, start, BAND, axis=1)
        s = jnp.einsum('bqhd,bkhd->bhqk', qc, kc).astype(jnp.float32) * scale + bias[None]
        valid = (start - pad + j) >= 0
        s = jnp.where(valid[None, None], s, NEG)
        p = jax.nn.softmax(s, axis=-1).astype(v.dtype)
        return jnp.einsum('bhqk,bkhd->bqhd', p, vc)

    out = lax.map(one_chunk, jnp.arange(n_chunks))
    return out.transpose(1, 0, 2, 3, 4).reshape(B, S, H * d)


def dsa_sparse_attention(q, k, v, iq, ik, iw):
    B, S, H, d = q.shape
    top_k = min(TOPK_MAX, S // 4)
    n_blocks = S // Q_BLOCK
    key_chunk = jnp.arange(S) // CHUNK
    scale = d ** -0.5
    gather = jax.vmap(lambda a, idx: a[idx])

    def one_block(blk):
        start = blk * Q_BLOCK
        qb = lax.dynamic_slice_in_dim(q, start, Q_BLOCK, axis=1)
        iqb = lax.dynamic_slice_in_dim(iq, start, Q_BLOCK, axis=1)
        iwb = lax.dynamic_slice_in_dim(iw, start, Q_BLOCK, axis=1)
        q_chunk = (start + jnp.arange(Q_BLOCK)) // CHUNK
        logits = jax.nn.relu(jnp.einsum('bqhd,bsd->bqhs', iqb, ik))
        score = jnp.einsum('bqhs,bqh->bqs', logits, iwb).astype(jnp.float32)
        adm = key_chunk[None, :] <= q_chunk[:, None]
        score = jnp.where(adm[None], score, -jnp.inf)
        _, idx = lax.top_k(score, top_k)
        sel_valid = (idx // CHUNK) <= q_chunk[None, :, None]
        ks = gather(k, idx)
        vs = gather(v, idx)
        s = jnp.einsum('bqhd,bqkd->bqhk', qb, ks).astype(jnp.float32) * scale
        s = jnp.where(sel_valid[:, :, None, :], s, NEG)
        p = jax.nn.softmax(s, axis=-1).astype(v.dtype)
        return jnp.einsum('bqhk,bqkd->bqhd', p, vs)

    out = lax.map(one_block, jnp.arange(n_blocks))
    return out.transpose(1, 0, 2, 3, 4).reshape(B, S, H * d)


def setup_inputs(seed: int = 0) -> dict:
    key = jax.random.key(seed)
    ks = jax.random.split(key, 10)
    nrm = jax.random.normal
    return {
        "x": nrm(ks[0], (BATCH, SEQ, D_MODEL), jnp.float32),
        "norm_gain": 1.0 + 0.05 * nrm(ks[1], (DEPTH, D_MODEL), jnp.float32),
        "w_in": nrm(ks[2], (DEPTH, D_MODEL, IN_WIDTH), jnp.float32) * D_MODEL ** -0.5,
        "b_merge": 0.05 * nrm(ks[3], (DEPTH, 2, D_MODEL), jnp.float32),
        "rel_bias": 0.2 * nrm(ks[4], (DEPTH, A_HEADS, 2 * REL_CLIP + 1), jnp.float32),
        "w_branch_a": nrm(ks[5], (DEPTH, A_WIDTH, D_MODEL), jnp.float32) * A_WIDTH ** -0.5,
        "w_branch_b": nrm(ks[6], (DEPTH, B_WIDTH, D_MODEL), jnp.float32) * B_WIDTH ** -0.5,
        "w_out": nrm(ks[7], (DEPTH, D_MODEL, D_MODEL), jnp.float32) * D_MODEL ** -0.5,
        "final_norm_gain": 1.0 + 0.05 * nrm(ks[8], (D_MODEL,), jnp.float32),
    }


def reference(x, norm_gain, w_in, b_merge, rel_bias, w_branch_a, w_branch_b, w_out, final_norm_gain):
    B, S, _ = x.shape
    offsets = [int(o) for o in np.cumsum(SPLIT_SIZES)[:-1]]
    h = x
    for layer in range(DEPTH):
        xn = rms_norm(h, norm_gain[layer])
        proj = xn @ w_in[layer]
        qa, ka, va, ga, qb, kb, vb, gb, iq, ik, iw, za, zb = jnp.split(proj, offsets, axis=-1)
        qa = qa.reshape(B, S, A_HEADS, A_HEAD_DIM)
        ka = ka.reshape(B, S, A_HEADS, A_HEAD_DIM)
        va = va.reshape(B, S, A_HEADS, A_HEAD_DIM)
        ya = chunked_relpos_attention(qa, ka, va, rel_bias[layer]) * jax.nn.silu(ga)
        qb = partial_rope(qb.reshape(B, S, B_HEADS, B_HEAD_DIM), ROT_DIM_B)
        kb = partial_rope(kb[:, :, None, :], ROT_DIM_B)[:, :, 0]
        iq = partial_rope(iq.reshape(B, S, IDX_HEADS, IDX_DIM), ROT_DIM_IDX)
        ik = partial_rope(ik[:, :, None, :], ROT_DIM_IDX)[:, :, 0]
        iw = iw * (IDX_HEADS ** -0.5 * IDX_DIM ** -0.5)
        yb = dsa_sparse_attention(qb, kb, vb, iq, ik, iw) * jax.nn.silu(gb)
        gate_a = jax.nn.sigmoid(za + b_merge[layer, 0])
        gate_b = jax.nn.sigmoid(zb + b_merge[layer, 1])
        merged = gate_a * (ya @ w_branch_a[layer]) + gate_b * (yb @ w_branch_b[layer])
        h = h + merged @ w_out[layer]
    return rms_norm(h, final_norm_gain)
```

```cpp
#include <hip/hip_runtime.h>
#include <cstdio>
#include <cstdint>

namespace nv {
constexpr int D = 1024, BATCH = 8, SEQ = 4096, T = BATCH * SEQ, INW = 5544;
constexpr int O_QA = 0, O_KA = 512, O_VA = 1024, O_GA = 1536, O_QB = 2048, O_KB = 2560, O_VB = 2624, O_GB = 2688,
              O_IQ = 3200, O_IK = 3456, O_IW = 3488, O_ZA = 3496, O_ZB = 4520;
constexpr float EPS = 1e-6f;

__device__ __forceinline__ float wave_sum(float v) {
#pragma unroll
    for (int o = 1; o < 64; o <<= 1) v += __shfl_xor(v, o);
    return v;
}
__global__ void rmsnorm_rows(const float* __restrict__ x, const float* __restrict__ r, const float* __restrict__ g, float* __restrict__ out, int rows) {
    const int lane = threadIdx.x & 63, row = blockIdx.x * (blockDim.x >> 6) + (threadIdx.x >> 6);
    if (row >= rows) return;
    float v[16]; float s = 0.f;
#pragma unroll
    for (int j = 0; j < 16; ++j) { const int c = lane + 64 * j; float t = x[(size_t)row * D + c]; if (r) t += r[(size_t)row * D + c]; v[j] = t; s += t * t; }
    s = wave_sum(s);
    const float rs = 1.0f / sqrtf(s * (1.0f / D) + EPS);
#pragma unroll
    for (int j = 0; j < 16; ++j) { const int c = lane + 64 * j; out[(size_t)row * D + c] = v[j] * rs * g[c]; }
}
__global__ void __launch_bounds__(256) sgemm(const float* __restrict__ A, const float* __restrict__ B, float* __restrict__ C, int M, int N, int K) {
    __shared__ float As[16][64 + 4];
    __shared__ float Bs[16][64 + 4];
    const int tx = threadIdx.x & 15, ty = threadIdx.x >> 4, m0 = blockIdx.y * 64, n0 = blockIdx.x * 64;
    float acc[4][4] = {};
    for (int k0 = 0; k0 < K; k0 += 16) {
        for (int i = threadIdx.x; i < 64 * 16; i += 256) { const int mm = i >> 4, kk = i & 15; As[kk][mm] = A[(size_t)(m0 + mm) * K + k0 + kk]; }
        for (int i = threadIdx.x; i < 64 * 16; i += 256) { const int kk = i >> 6, nn = i & 63; Bs[kk][nn] = (n0 + nn < N) ? B[(size_t)(k0 + kk) * N + n0 + nn] : 0.f; }
        __syncthreads();
#pragma unroll
        for (int kk = 0; kk < 16; ++kk) {
            float a[4], b[4];
#pragma unroll
            for (int i = 0; i < 4; ++i) { a[i] = As[kk][ty * 4 + i]; b[i] = Bs[kk][tx * 4 + i]; }
#pragma unroll
            for (int i = 0; i < 4; ++i)
#pragma unroll
                for (int j = 0; j < 4; ++j) acc[i][j] = fmaf(a[i], b[j], acc[i][j]);
        }
        __syncthreads();
    }
#pragma unroll
    for (int i = 0; i < 4; ++i)
#pragma unroll
        for (int j = 0; j < 4; ++j) { const int n = n0 + tx * 4 + j; if (n < N) C[(size_t)(m0 + ty * 4 + i) * N + n] = acc[i][j]; }
}
__device__ __forceinline__ void sincos_acc(float angf, float& c, float& s) {
    const double a = (double)angf;
    const double k = rint(a * 0.63661977236758134308);
    const double r = (a - k * 1.5707963267948966192) - k * 6.123233995736766e-17;
    const double r2 = r * r;
    double sp = r * (1.0 + r2 * (-1.0 / 6 + r2 * (1.0 / 120 + r2 * (-1.0 / 5040 + r2 * (1.0 / 362880 + r2 * (-1.0 / 39916800 + r2 * (1.0 / 6227020800.0 + r2 * (-1.0 / 1307674368000.0))))))));
    double cp = 1.0 + r2 * (-0.5 + r2 * (1.0 / 24 + r2 * (-1.0 / 720 + r2 * (1.0 / 40320 + r2 * (-1.0 / 3628800 + r2 * (1.0 / 479001600.0 + r2 * (-1.0 / 87178291200.0 + r2 * (1.0 / 20922789888000.0))))))));
    const int q = ((int)(long long)k) & 3;
    double sv = (q == 0) ? sp : (q == 1) ? cp : (q == 2) ? -sp : -cp;
    double cv = (q == 0) ? cp : (q == 1) ? -sp : (q == 2) ? -cp : sp;
    c = (float)cv; s = (float)sv;
}
__global__ void rope_fix(float* __restrict__ P, int rows) {
    const int idx = blockIdx.x * blockDim.x + threadIdx.x;
    const int row = idx / 112, it = idx % 112;
    if (row >= rows) return;
    const int pos = row % SEQ;
    float* p = P + (size_t)row * INW;
    int base, half, i;
    if (it < 64) { base = O_QB + (it >> 3) * 64; half = 8; i = it & 7; }
    else if (it < 72) { base = O_KB; half = 8; i = it - 64; }
    else if (it < 104) { base = O_IQ + ((it - 72) >> 2) * 32; half = 4; i = (it - 72) & 3; }
    else if (it < 108) { base = O_IK; half = 4; i = it - 104; }
    else if (it == 108) { for (int j = 0; j < 8; ++j) p[O_IW + j] *= 0.0625f; return; }
    else return;
    const float inv = powf(500000.0f, -(float)i / (float)half);
    const float ang = (float)pos * inv;
    float c, s; sincos_acc(ang, c, s);
    const float x1 = p[base + i], x2 = p[base + half + i];
    p[base + i] = x1 * c - x2 * s; p[base + half + i] = x2 * c + x1 * s;
}
__device__ __forceinline__ float silu(float v) { return v / (1.0f + expf(-v)); }
__device__ __forceinline__ float sigm(float v) { return 1.0f / (1.0f + expf(-v)); }
__global__ void __launch_bounds__(64) attn_a(const float* __restrict__ P, const float* __restrict__ relb, float* __restrict__ YA) {
    const int idx = blockIdx.x * blockDim.x + threadIdx.x; const int t = idx >> 3, h = idx & 7;
    if (t >= SEQ) return;
    const int c = t >> 6;
    float q[64];
#pragma unroll
    for (int d = 0; d < 64; ++d) q[d] = P[(size_t)t * INW + O_QA + h * 64 + d];
    float o[64];
#pragma unroll
    for (int d = 0; d < 64; ++d) o[d] = 0.f;
    float m = -3.0e38f, l = 0.f;
    const int s_lo = (c - 8 < 0 ? 0 : c - 8) * 64, s_hi = (c + 1) * 64;
    for (int s = s_lo; s < s_hi; ++s) {
        const float* kr = P + (size_t)s * INW + O_KA + h * 64;
        float dot = 0.f;
#pragma unroll
        for (int d = 0; d < 64; ++d) dot = fmaf(q[d], kr[d], dot);
        int dist = t - s; dist = dist > 256 ? 256 : (dist < -256 ? -256 : dist);
        const float sc = dot * 0.125f + relb[h * 513 + dist + 256];
        const float mn = fmaxf(m, sc), a = expf(m - mn), pp = expf(sc - mn);
        l = l * a + pp; m = mn;
        const float* vr = P + (size_t)s * INW + O_VA + h * 64;
#pragma unroll
        for (int d = 0; d < 64; ++d) o[d] = o[d] * a + pp * vr[d];
    }
    const float il = 1.0f / l;
#pragma unroll
    for (int d = 0; d < 64; ++d) YA[(size_t)t * 512 + h * 64 + d] = o[d] * il * silu(P[(size_t)t * INW + O_GA + h * 64 + d]);
}
__device__ __forceinline__ unsigned fkey(float f) { const unsigned u = __float_as_uint(f); return (u & 0x80000000u) ? ~u : (u | 0x80000000u); }
__global__ void __launch_bounds__(256) dsa_b(const float* __restrict__ P, float* __restrict__ YB) {
    __shared__ unsigned keys[4096];
    __shared__ float iqs[256], iws[8], qs[512];
    __shared__ int sel[256];
    __shared__ float sc[8][256];
    __shared__ float mx[8], sm[8];
    __shared__ int cnt, cnt2;
    const int t = blockIdx.x, tid = threadIdx.x, c = t >> 6, n = (c + 1) * 64;
    const float* pr = P + (size_t)t * INW;
    iqs[tid] = pr[O_IQ + tid]; if (tid < 8) iws[tid] = pr[O_IW + tid];
    qs[tid] = pr[O_QB + tid]; qs[tid + 256] = pr[O_QB + 256 + tid];
    __syncthreads();
    int nsel;
    if (n <= 256) { nsel = n; if (tid < n) sel[tid] = tid; __syncthreads(); }
    else {
        for (int s = tid; s < n; s += 256) {
            const float* ik = P + (size_t)s * INW + O_IK; float ikr[32];
#pragma unroll
            for (int d = 0; d < 32; ++d) ikr[d] = ik[d];
            float score = 0.f;
#pragma unroll 1
            for (int h = 0; h < 8; ++h) { float dot = 0.f;
#pragma unroll
                for (int d = 0; d < 32; ++d) dot = fmaf(iqs[h * 32 + d], ikr[d], dot);
                score += fmaxf(dot, 0.f) * iws[h]; }
            keys[s] = fkey(score);
        }
        __syncthreads();
        unsigned cur = 0;
        for (int bit = 31; bit >= 0; --bit) {
            const unsigned trial = cur | (1u << bit);
            if (tid == 0) cnt = 0;
            __syncthreads();
            int my = 0; for (int s = tid; s < n; s += 256) my += (keys[s] >= trial) ? 1 : 0;
            if (my) atomicAdd(&cnt, my);
            __syncthreads();
            if (cnt >= 256) cur = trial;
            __syncthreads();
        }
        if (tid == 0) cnt = 0;
        __syncthreads();
        for (int s = tid; s < n; s += 256) if (keys[s] > cur) { const int p = atomicAdd(&cnt, 1); sel[p] = s; }
        __syncthreads();
        if (tid == 0) { int cc = cnt; for (int s = 0; s < n && cc < 256; ++s) if (keys[s] == cur) sel[cc++] = s; }
        __syncthreads();
        nsel = 256;
    }
    if (tid < nsel) {
        const float* kr = P + (size_t)sel[tid] * INW + O_KB; float kk[64];
#pragma unroll
        for (int d = 0; d < 64; ++d) kk[d] = kr[d];
        for (int h = 0; h < 8; ++h) { float dot = 0.f;
#pragma unroll
            for (int d = 0; d < 64; ++d) dot = fmaf(qs[h * 64 + d], kk[d], dot);
            sc[h][tid] = dot * 0.125f; }
    }
    __syncthreads();
    if (tid < 8) { float m = -3.0e38f; for (int k = 0; k < nsel; ++k) m = fmaxf(m, sc[tid][k]); float s = 0.f; for (int k = 0; k < nsel; ++k) s += expf(sc[tid][k] - m); mx[tid] = m; sm[tid] = s; }
    __syncthreads();
#pragma unroll 1
    for (int h = 0; h < 8; ++h) if (tid < nsel) sc[h][tid] = expf(sc[h][tid] - mx[h]) / sm[h];
    __syncthreads();
    for (int o = tid; o < 512; o += 256) { const int h = o >> 6, d = o & 63; float a = 0.f;
#pragma unroll 4
        for (int k = 0; k < nsel; ++k) a = fmaf(sc[h][k], P[(size_t)sel[k] * INW + O_VB + d], a);
        YB[(size_t)t * 512 + o] = a * silu(pr[O_GB + o]); }
}
__global__ void merge_k(const float* __restrict__ P, const float* __restrict__ bm, const float* __restrict__ U, const float* __restrict__ V, float* __restrict__ Mg, int rows) {
    const size_t i = (size_t)blockIdx.x * blockDim.x + threadIdx.x; if (i >= (size_t)rows * D) return;
    const int row = (int)(i >> 10), col = (int)(i & 1023);
    const float ga = sigm(P[(size_t)row * INW + O_ZA + col] + bm[col]), gb = sigm(P[(size_t)row * INW + O_ZB + col] + bm[D + col]);
    Mg[i] = ga * U[i] + gb * V[i];
}
}

extern "C" void kernel_launch(void* const* d_in, const int* in_sizes, int n_in, void* d_out, int out_size, void* d_ws, size_t ws_size, hipStream_t stream) {
    using namespace nv;
    const float* x = (const float*)d_in[0]; const float* g1 = (const float*)d_in[1]; const float* w_in = (const float*)d_in[2]; const float* bm = (const float*)d_in[3];
    const float* relb = (const float*)d_in[4]; const float* wa = (const float*)d_in[5]; const float* wb = (const float*)d_in[6]; const float* wo = (const float*)d_in[7]; const float* g2 = (const float*)d_in[8];
    float* out = (float*)d_out;
    char* ws = (char*)d_ws; size_t off = 0;
    auto carve = [&](size_t bytes) { void* p = ws + off; off += (bytes + 255) & ~(size_t)255; return p; };
    float* XN = (float*)carve((size_t)SEQ * D * 4);
    float* PR = (float*)carve((size_t)SEQ * INW * 4);
    float* YA = (float*)carve((size_t)SEQ * 512 * 4);
    float* YB = (float*)carve((size_t)SEQ * 512 * 4);
    float* U = (float*)carve((size_t)SEQ * D * 4);
    float* V = (float*)carve((size_t)SEQ * D * 4);
    float* MG = (float*)carve((size_t)SEQ * D * 4);
    float* Y3 = (float*)carve((size_t)SEQ * D * 4);
    if (off > ws_size) { fprintf(stderr, "ws too small\n"); return; }
    for (int b = 0; b < BATCH; ++b) {
        const float* xb = x + (size_t)b * SEQ * D; float* ob = out + (size_t)b * SEQ * D;
        rmsnorm_rows<<<SEQ / 4, 256, 0, stream>>>(xb, nullptr, g1, XN, SEQ);
        sgemm<<<dim3((INW + 63) / 64, SEQ / 64), 256, 0, stream>>>(XN, w_in, PR, SEQ, INW, D);
        rope_fix<<<(SEQ * 112 + 255) / 256, 256, 0, stream>>>(PR, SEQ);
        attn_a<<<SEQ * 8 / 64, 64, 0, stream>>>(PR, relb, YA);
        dsa_b<<<SEQ, 256, 0, stream>>>(PR, YB);
        sgemm<<<dim3(D / 64, SEQ / 64), 256, 0, stream>>>(YA, wa, U, SEQ, D, 512);
        sgemm<<<dim3(D / 64, SEQ / 64), 256, 0, stream>>>(YB, wb, V, SEQ, D, 512);
        merge_k<<<(SEQ * D) / 256, 256, 0, stream>>>(PR, bm, U, V, MG, SEQ);
        sgemm<<<dim3(D / 64, SEQ / 64), 256, 0, stream>>>(MG, wo, Y3, SEQ, D, D);
        rmsnorm_rows<<<SEQ / 4, 256, 0, stream>>>(xb, Y3, g2, ob, SEQ);
    }
}
```

```cpp
#include <hip/hip_runtime.h>
#include <cstdio>
#include <cstdint>
namespace pg8 {
#define PG8_LAS __attribute__((address_space(3)))
typedef unsigned short bf16_t;
typedef _Float16 bf16x8 __attribute__((ext_vector_type(8)));
typedef float f32x4 __attribute__((ext_vector_type(4)));
typedef unsigned u32x4 __attribute__((ext_vector_type(4)));
constexpr int BM = 256, BK = 64, HALF = 128, HTB = HALF * BK * 2  , STAGE_BYTES = 8 * HTB, NXCD = 8, WGM = 8;

__host__ __device__ __forceinline__ int lds_byte(int r, int c) { const int st = (r >> 4) * 2 + (c >> 5), rr = r & 15, cc = c & 31, ob = rr * 64 + cc * 2; return st * 1024 + (ob ^ (((ob >> 9) & 1) << 5)); }
__host__ __device__ __forceinline__ void stage_rc(int b, int& R, int& C) { const int st = b / 1024, sb = b % 1024, swz = sb ^ (((sb >> 9) & 1) << 5); R = (st >> 1) * 16 + swz / 64; C = (st & 1) * 32 + (swz % 64) / 2; }
__host__ __device__ __forceinline__ int perm32(int rho) { const int n = rho >> 4, i = rho & 15; return 8 * (i >> 2) + 4 * n + (i & 3); }

struct Unit { int pm, pn; };
struct Gemm { const bf16_t* A; const bf16_t* Bt; int M, N, K; };

struct StaticOrder {
    int nM, nN, nwg, G, c;
    __host__ __device__ void init(int M, int N, int G_, int c_) { nM = M / BM; nN = N / BM; nwg = nM * nN; G = G_; c = c_; }
    __host__ __device__ bool next(int i, Unit& u) const {
        const long L = (long)i * G + c; if (L >= nwg) return false;
        int wgid = (int)L; { const int q = nwg / NXCD, r = nwg % NXCD, xcd = wgid % NXCD, off = wgid / NXCD; wgid = (xcd < r ? xcd * (q + 1) : r * (q + 1) + (xcd - r) * q) + off; }
        const int nig = WGM * nN, gid = wgid / nig, fm = gid * WGM, gsz = (nM - fm) < WGM ? (nM - fm) : WGM;
        u.pm = fm + ((wgid % nig) % gsz); u.pn = (wgid % nig) / gsz; return true;
    }
    __device__ __forceinline__ void a_ready(const Unit&) const {}
    __device__ __forceinline__ void done(const Unit&) const {}
};


template <class Epi, class Sched, bool ALIGN_EPI = false, bool SP2 = false>
__device__ __forceinline__ void gemm_phase(PG8_LAS unsigned char* lds, const Gemm g, const Sched& S, const Epi& E) {
    const int tid = threadIdx.x, wid = __builtin_amdgcn_readfirstlane(tid >> 6), lane = tid & 63, wr = wid >> 2, wc = wid & 3, fr = lane & 15, fq = lane >> 4;
    const int K = g.K, nt = K / BK;
    unsigned voffA[2], voffB[2];
#pragma unroll
    for (int i = 0; i < 2; ++i) { int R, C; stage_rc(tid * 16 + i * 8192, R, C); const int Rb = Epi::PERM ? ((R & ~31) + perm32(R & 31)) : R;
        voffA[i] = (unsigned)(R * K + C) * 2u; voffB[i] = (unsigned)(Rb * K + C) * 2u; }
    const size_t kstep = (size_t)(BK * 2);
    const size_t hstep = (size_t)HALF * K * 2;
    const size_t tstep = 2 * hstep;
    const unsigned ldsw = (unsigned)wid * 1024u;
    const int aoff = lds_byte(wr * 64 + fr, fq * 8), boff = lds_byte(wc * 32 + fr, fq * 8);
#define PG8_SA(b, h) (((b) * 2 + (h)) * HTB)
#define PG8_SB(b, h) ((4 + (b) * 2 + (h)) * HTB)
#define PG8_STAGE(bufoff, gbase, voff) do { _Pragma("unroll") for (int _i = 0; _i < 2; ++_i) \
        __builtin_amdgcn_global_load_lds((const unsigned*)((const char*)(gbase) + (voff)[_i]), (PG8_LAS unsigned*)(lds + (bufoff) + ldsw + _i * 8192), 16, 0, 0); } while (0)
#define PG8_LDA(dst, b, h) do { _Pragma("unroll") for (int m = 0; m < 4; ++m) _Pragma("unroll") for (int k = 0; k < 2; ++k) dst[m][k] = *(const PG8_LAS bf16x8*)(lds + PG8_SA(b, h) + aoff + m * 2048 + k * 1024); } while (0)
#define PG8_LDB(dst, b, h) do { _Pragma("unroll") for (int n = 0; n < 2; ++n) _Pragma("unroll") for (int k = 0; k < 2; ++k) dst[n][k] = *(const PG8_LAS bf16x8*)(lds + PG8_SB(b, h) + boff + n * 2048 + k * 1024); } while (0)
#define PG8_MMA(ai, bj, At, Bt) do { __builtin_amdgcn_s_setprio(1); _Pragma("unroll") for (int m = 0; m < 4; ++m) _Pragma("unroll") for (int n = 0; n < 2; ++n) _Pragma("unroll") for (int k = 0; k < 2; ++k) \
        acc[ai][bj][m][n] = __builtin_amdgcn_mfma_f32_16x16x32_f16(Bt[n][k], At[m][k], acc[ai][bj][m][n], 0, 0, 0); __builtin_amdgcn_s_setprio(0); } while (0)
#define PG8_WAIT_V(n) asm volatile("s_waitcnt vmcnt(" #n ")" ::: "memory")
#define PG8_WAIT_L(n) asm volatile("s_waitcnt lgkmcnt(" #n ")" ::: "memory")
#define PG8_BAR __builtin_amdgcn_s_barrier()
#define PG8_SCHED __builtin_amdgcn_sched_barrier(0)
    Unit cur, nxt; int ui = 0;
    if (!S.next(0, cur)) return;
    f32x4 acc[2][2][4][2];
#pragma unroll
    for (int a = 0; a < 2; ++a)
#pragma unroll
        for (int b = 0; b < 2; ++b)
#pragma unroll
            for (int m = 0; m < 4; ++m)
#pragma unroll
                for (int n = 0; n < 2; ++n) acc[a][b][m][n] = (f32x4){0.f, 0.f, 0.f, 0.f};
    bf16x8 At[4][2], B0[2][2], B1[2][2];
    const char* cA = (const char*)g.A + (size_t)cur.pm * tstep; const char* cB = (const char*)g.Bt + (size_t)cur.pn * tstep;
    S.a_ready(cur);
    if constexpr (SP2) {
        PG8_STAGE(PG8_SB(0, 0), cB, voffB); PG8_STAGE(PG8_SB(0, 1), cB + hstep, voffB); PG8_STAGE(PG8_SA(0, 0), cA, voffA); PG8_STAGE(PG8_SA(0, 1), cA + hstep, voffA);
        if (wr == 1) PG8_BAR;
        PG8_WAIT_V(2); PG8_BAR;
        PG8_STAGE(PG8_SB(1, 0), cB + kstep, voffB); PG8_STAGE(PG8_SA(1, 0), cA + kstep, voffA); PG8_STAGE(PG8_SB(1, 1), cB + hstep + kstep, voffB);
        PG8_WAIT_V(6); PG8_BAR;
    } else {
        PG8_STAGE(PG8_SB(0, 0), cB, voffB); PG8_STAGE(PG8_SA(0, 0), cA, voffA); PG8_STAGE(PG8_SB(0, 1), cB + hstep, voffB); PG8_STAGE(PG8_SA(0, 1), cA + hstep, voffA);
        if (wr == 1) PG8_BAR;
        PG8_WAIT_V(4); PG8_BAR;
        PG8_STAGE(PG8_SB(1, 0), cB + kstep, voffB); PG8_STAGE(PG8_SA(1, 0), cA + kstep, voffA); PG8_STAGE(PG8_SB(1, 1), cB + hstep + kstep, voffB);
        PG8_WAIT_V(6); PG8_BAR;
    }
    for (;;) {
        const bool has_next = S.next(ui + 1, nxt);
        const char* nA = has_next ? (const char*)g.A + (size_t)nxt.pm * tstep : cA; const char* nB = has_next ? (const char*)g.Bt + (size_t)nxt.pn * tstep : cB;
        for (int t = 0; t < nt; t += 2) {
            const bool last = (t == nt - 2);
            const char* a1 = cA + (size_t)(t + 1) * kstep;
            const char* a2 = last ? nA : cA + (size_t)(t + 2) * kstep; const char* b2 = last ? nB : cB + (size_t)(t + 2) * kstep;
            const char* a3 = a2 + kstep; const char* b3 = b2 + kstep;
            if (last && has_next) S.a_ready(nxt);
            if constexpr (SP2) {
            PG8_LDB(B0, 0, 0); PG8_LDB(B1, 0, 1); PG8_SCHED; PG8_LDA(At, 0, 0); PG8_STAGE(PG8_SA(1, 1), a1 + hstep, voffA);
            PG8_WAIT_V(8); PG8_WAIT_L(0); PG8_BAR; PG8_MMA(0, 0, At, B0); PG8_MMA(0, 1, At, B1); PG8_BAR; PG8_SCHED;
            PG8_LDA(At, 0, 1); PG8_STAGE(PG8_SB(0, 0), b2, voffB); PG8_STAGE(PG8_SB(0, 1), b2 + hstep, voffB); PG8_STAGE(PG8_SA(0, 0), a2, voffA);
            PG8_WAIT_V(8); PG8_WAIT_L(0); PG8_BAR; PG8_MMA(1, 0, At, B0); PG8_MMA(1, 1, At, B1); PG8_BAR; PG8_SCHED;
            PG8_LDB(B0, 1, 0); PG8_LDB(B1, 1, 1); PG8_SCHED; PG8_LDA(At, 1, 0); PG8_STAGE(PG8_SA(0, 1), a2 + hstep, voffA);
            PG8_WAIT_V(8); PG8_WAIT_L(0); PG8_BAR; PG8_MMA(0, 0, At, B0); PG8_MMA(0, 1, At, B1); PG8_BAR; PG8_SCHED;
            PG8_LDA(At, 1, 1); PG8_STAGE(PG8_SB(1, 0), b3, voffB); PG8_STAGE(PG8_SB(1, 1), b3 + hstep, voffB); PG8_STAGE(PG8_SA(1, 0), a3, voffA);
            PG8_WAIT_V(8); PG8_WAIT_L(0); PG8_BAR; PG8_MMA(1, 0, At, B0); PG8_MMA(1, 1, At, B1); PG8_BAR; PG8_SCHED;
            } else {
            PG8_LDB(B0, 0, 0); PG8_SCHED; PG8_LDA(At, 0, 0); PG8_STAGE(PG8_SA(1, 1), a1 + hstep, voffA);
            PG8_WAIT_L(8); PG8_BAR; PG8_WAIT_L(0); PG8_MMA(0, 0, At, B0); PG8_BAR; PG8_SCHED;
            PG8_LDB(B1, 0, 1); PG8_STAGE(PG8_SB(0, 0), b2, voffB);
            PG8_BAR; PG8_WAIT_L(0); PG8_MMA(0, 1, At, B1); PG8_BAR;
            PG8_LDA(At, 0, 1); PG8_STAGE(PG8_SA(0, 0), a2, voffA);
            PG8_BAR; PG8_WAIT_L(0); PG8_MMA(1, 0, At, B0); PG8_BAR; PG8_SCHED;
            PG8_STAGE(PG8_SB(0, 1), b2 + hstep, voffB);
            PG8_WAIT_V(6); PG8_BAR; PG8_MMA(1, 1, At, B1); PG8_BAR;
            PG8_LDB(B0, 1, 0); PG8_SCHED; PG8_LDA(At, 1, 0); PG8_STAGE(PG8_SA(0, 1), a2 + hstep, voffA);
            PG8_WAIT_L(8); PG8_BAR; PG8_WAIT_L(0); PG8_MMA(0, 0, At, B0); PG8_BAR; PG8_SCHED;
            PG8_LDB(B1, 1, 1); PG8_STAGE(PG8_SB(1, 0), b3, voffB);
            PG8_BAR; PG8_WAIT_L(0); PG8_MMA(0, 1, At, B1); PG8_BAR;
            PG8_LDA(At, 1, 1); PG8_STAGE(PG8_SA(1, 0), a3, voffA);
            PG8_BAR; PG8_WAIT_L(0); PG8_MMA(1, 0, At, B0); PG8_BAR; PG8_SCHED;
            PG8_STAGE(PG8_SB(1, 1), b3 + hstep, voffB);
            PG8_WAIT_V(6); PG8_BAR; PG8_MMA(1, 1, At, B1); PG8_BAR;
            }
        }
        if constexpr (ALIGN_EPI) { if (wr == 0) PG8_BAR; }
        if constexpr (!Epi::AFTER_DRAIN) { E(acc, cur, wr, wc, fr, fq); S.done(cur); }
        if (!has_next) break;
#pragma unroll
        for (int a = 0; a < 2; ++a)
#pragma unroll
            for (int b = 0; b < 2; ++b)
#pragma unroll
                for (int m = 0; m < 4; ++m)
#pragma unroll
                    for (int n = 0; n < 2; ++n) acc[a][b][m][n] = (f32x4){0.f, 0.f, 0.f, 0.f};
        cur = nxt; cA = nA; cB = nB; ++ui;
        if constexpr (ALIGN_EPI) { if (wr == 1) PG8_BAR; }
    }
    PG8_WAIT_V(0);
    if constexpr (!ALIGN_EPI) { if (wr == 0) PG8_BAR; }
    PG8_BAR;
    if constexpr (Epi::AFTER_DRAIN) { E.fused(acc, cur, wr, wc, fr, fq, lds, wid, lane); S.done(cur); }
#undef PG8_SA
#undef PG8_SB
#undef PG8_STAGE
#undef PG8_LDA
#undef PG8_LDB
#undef PG8_MMA
#undef PG8_WAIT_V
#undef PG8_WAIT_L
#undef PG8_BAR
#undef PG8_SCHED
}
}


#define LAS __attribute__((address_space(3)))
#define GAS __attribute__((address_space(1)))
typedef _Float16 h16;
typedef _Float16 h16x8 __attribute__((ext_vector_type(8)));
typedef _Float16 h16x4 __attribute__((ext_vector_type(4)));
typedef _Float16 h16x2 __attribute__((ext_vector_type(2)));
typedef float f32x2 __attribute__((ext_vector_type(2)));
typedef float f32x4 __attribute__((ext_vector_type(4)));
typedef float f32x16 __attribute__((ext_vector_type(16)));
typedef unsigned u32x4 __attribute__((ext_vector_type(4)));
typedef unsigned u32x2 __attribute__((ext_vector_type(2)));
typedef short s16x4 __attribute__((ext_vector_type(4)));

constexpr int NWAVES = 8;
constexpr int DM = 1024, NBATCH = 8, SEQ = 4096, T = NBATCH * SEQ, INW = 5544;
constexpr int NPHYS = 5632;
constexpr int NMAIN = 5120;
constexpr float EPS = 1e-6f;
constexpr float LOG2E = 1.4426950408889634f;
constexpr float QSCALE = 0.125f * LOG2E;
#ifndef MK_N_LAUNCHES
#define MK_N_LAUNCHES 1
#endif
constexpr int N_LAUNCHES = MK_N_LAUNCHES;
constexpr int PER_PHASE = 6;

constexpr size_t MiB = 1u << 20;
constexpr size_t WS_CTL = 0, CTL_ZERO_BYTES = 1 * MiB;
constexpr size_t WS_WIN = 2 * MiB, WS_WA = 13 * MiB, WS_WB = 14 * MiB, WS_WOUT = 15 * MiB;
constexpr size_t WS_ROPEB = 17 * MiB, WS_ROPEI = WS_ROPEB + 256 * 1024, WS_BIAS = WS_ROPEI + 128 * 1024;
constexpr size_t WS_IW = 18 * MiB, WS_IK = 19 * MiB, WS_KVB = 21 * MiB, WS_IQ = 29 * MiB;
constexpr size_t WS_XN = 48 * MiB;
constexpr size_t WS_QA = 112 * MiB, WS_KA = 144 * MiB, WS_VAT = 176 * MiB, WS_GA = 208 * MiB, WS_QB = 240 * MiB, WS_GB = 272 * MiB;
constexpr size_t WS_GTA = 304 * MiB, WS_GTB = 368 * MiB, WS_END = 432 * MiB;
constexpr int CW_BAR = 4096;

constexpr int RING_BYTES = 131072;
constexpr int LDS_HIST = 131072, LDS_IDX = LDS_HIST + 8 * 2048, LDSCTL_OFF = LDS_IDX + 8 * 512, MISC_OFF = LDSCTL_OFF + 320;
constexpr int LDS_BYTES = LDSCTL_OFF + 1024;

__device__ __forceinline__ unsigned pkh(float lo, float hi) { f32x2 v = {lo, hi}; h16x2 h = __builtin_convertvector(v, h16x2); return __builtin_bit_cast(unsigned, h); }
__device__ __forceinline__ float fexp2(float x) { return __builtin_amdgcn_exp2f(x); }
__device__ __forceinline__ float frcp(float x) { return __builtin_amdgcn_rcpf(x); }
__device__ __forceinline__ float sigmoidf_(float v) { return frcp(1.0f + fexp2(-v * LOG2E)); }
__device__ __forceinline__ float siluf_(float v) { return v * sigmoidf_(v); }
__device__ __forceinline__ float wave_sum(float v) {
#pragma unroll
    for (int o = 1; o < 64; o <<= 1) v += __shfl_xor(v, o);
    return v;
}
__device__ __forceinline__ float wave_max(float v) {
#pragma unroll
    for (int o = 1; o < 64; o <<= 1) v = fmaxf(v, __shfl_xor(v, o));
    return v;
}
__device__ __forceinline__ float wave_min(float v) {
#pragma unroll
    for (int o = 1; o < 64; o <<= 1) v = fminf(v, __shfl_xor(v, o));
    return v;
}
__device__ __forceinline__ unsigned wave_sum_u(unsigned v) {
#pragma unroll
    for (int o = 1; o < 64; o <<= 1) v += __shfl_xor(v, o);
    return v;
}

namespace epi {
using pg8::Unit;
__device__ __forceinline__ void store8(h16* p, const f32x4& a, const f32x4& b) {
    u32x4 w; w.x = pkh(a[0], a[1]); w.y = pkh(a[2], a[3]); w.z = pkh(b[0], b[1]); w.w = pkh(b[2], b[3]); *(u32x4*)p = w;
}
__device__ __forceinline__ void rope4(f32x4& v0, f32x4& v1, const float* tab) {
    const f32x4 t0 = *(const f32x4*)tab, t1 = *(const f32x4*)(tab + 4);
    float a, b;
    a = v0[0]; b = v0[1]; v0[0] = a * t0[0] - b * t0[1]; v0[1] = b * t0[0] + a * t0[1];
    a = v0[2]; b = v0[3]; v0[2] = a * t0[2] - b * t0[3]; v0[3] = b * t0[2] + a * t0[3];
    a = v1[0]; b = v1[1]; v1[0] = a * t1[0] - b * t1[1]; v1[1] = b * t1[0] + a * t1[1];
    a = v1[2]; b = v1[3]; v1[2] = a * t1[2] - b * t1[3]; v1[3] = b * t1[2] + a * t1[3];
}
struct EpiProj {
    static constexpr bool PERM = true, AFTER_DRAIN = false;
    h16 *QA, *KA, *GA, *QB, *GB, *GTA, *GTB, *KVB, *IQ, *IK; float* IW; const float* bm; const float* ropeb; const float* ropei;
    __device__ __forceinline__ void operator()(const f32x4 (&acc)[2][2][4][2], const Unit& u, int wr, int wc, int fr, int fq) const {
        const int pn = u.pn, row0 = u.pm * 256 + wr * 64 + fr;
        if (pn < 18) {
            h16* base; int ldc, colt, kind; const float* bias = nullptr;
            if (pn < 2) { base = QA; ldc = 512; colt = 256 * pn; kind = 1; }
            else if (pn < 4) { base = KA; ldc = 512; colt = 256 * (pn - 2); kind = 0; }
            else if (pn < 6) { base = GA; ldc = 512; colt = 256 * (pn - 4); kind = 2; }
            else if (pn < 8) { base = QB; ldc = 512; colt = 256 * (pn - 6); kind = 4; }
            else if (pn < 10) { base = GB; ldc = 512; colt = 256 * (pn - 8); kind = 2; }
            else if (pn < 14) { base = GTA; ldc = 1024; colt = 256 * (pn - 10); kind = 3; bias = bm + colt; }
            else { base = GTB; ldc = 1024; colt = 256 * (pn - 14); kind = 3; bias = bm + 1024 + colt; }
            const int cl = wc * 32 + 8 * fq;
            f32x4 bv[2][2];
#pragma unroll
            for (int bj = 0; bj < 2; ++bj)
#pragma unroll
                for (int n = 0; n < 2; ++n) bv[bj][n] = (kind == 3) ? *(const f32x4*)(bias + bj * 128 + cl + 4 * n) : (f32x4){0.f, 0.f, 0.f, 0.f};
            const bool ropel = (kind == 4) && ((wc & 1) == 0) && (fq < 2);
#pragma unroll
            for (int ai = 0; ai < 2; ++ai)
#pragma unroll
                for (int m = 0; m < 4; ++m) {
                    const int row = row0 + ai * 128 + m * 16;
                    h16* rowp = base + (size_t)row * ldc + colt + cl;
#pragma unroll
                    for (int bj = 0; bj < 2; ++bj) {
                        f32x4 v0 = acc[ai][bj][m][0], v1 = acc[ai][bj][m][1];
                        if (kind == 1) { v0 = v0 * QSCALE; v1 = v1 * QSCALE; }
                        else if (kind == 2) {
#pragma unroll
                            for (int e = 0; e < 4; ++e) { v0[e] = siluf_(v0[e]); v1[e] = siluf_(v1[e]); }
                        } else if (kind == 3) {
                            v0 = v0 + bv[bj][0]; v1 = v1 + bv[bj][1];
#pragma unroll
                            for (int e = 0; e < 4; ++e) { v0[e] = sigmoidf_(v0[e]); v1[e] = sigmoidf_(v1[e]); }
                        } else if (kind == 4) {
                            if (ropel) rope4(v0, v1, ropeb + (size_t)(row & (SEQ - 1)) * 16 + fq * 8);
                            v0 = v0 * QSCALE; v1 = v1 * QSCALE;
                        }
                        store8(rowp + bj * 128, v0, v1);
                    }
                }
        } else {
#pragma unroll
            for (int bj = 0; bj < 2; ++bj) {
                const int G = (pn - 18) * 8 + bj * 4 + wc;
                if (G >= 14) continue;
#pragma unroll
                for (int ai = 0; ai < 2; ++ai)
#pragma unroll
                    for (int m = 0; m < 4; ++m) {
                        const int row = row0 + ai * 128 + m * 16, pos = row & (SEQ - 1);
                        f32x4 v0 = acc[ai][bj][m][0], v1 = acc[ai][bj][m][1];
                        if (G < 4) {
                            if (G == 0 && fq < 2) rope4(v0, v1, ropeb + (size_t)pos * 16 + fq * 8);
                            store8(KVB + (size_t)row * 128 + G * 32 + 8 * fq, v0, v1);
                        } else if (G < 12) {
                            if (fq == 0) rope4(v0, v1, ropei + (size_t)pos * 8);
                            store8(IQ + (size_t)row * 256 + (G - 4) * 32 + 8 * fq, v0, v1);
                        } else if (G == 12) {
                            if (fq == 0) rope4(v0, v1, ropei + (size_t)pos * 8);
                            store8(IK + (size_t)row * 32 + 8 * fq, v0, v1);
                        } else {
                            if (fq == 0) { *(f32x4*)(IW + (size_t)row * 8) = v0 * 0.0625f; *(f32x4*)(IW + (size_t)row * 8 + 4) = v1 * 0.0625f; }
                        }
                    }
            }
        }
    }
};
struct EpiPlain {
    static constexpr bool PERM = true, AFTER_DRAIN = false;
    h16* C; int ldc;
    __device__ __forceinline__ void operator()(const f32x4 (&acc)[2][2][4][2], const Unit& u, int wr, int wc, int fr, int fq) const {
        const int row0 = u.pm * 256 + wr * 64 + fr, col0 = u.pn * 256 + wc * 32 + 8 * fq;
#pragma unroll
        for (int ai = 0; ai < 2; ++ai)
#pragma unroll
            for (int m = 0; m < 4; ++m) { h16* rowp = C + (size_t)(row0 + ai * 128 + m * 16) * ldc + col0;
#pragma unroll
                for (int bj = 0; bj < 2; ++bj) store8(rowp + bj * 128, acc[ai][bj][m][0], acc[ai][bj][m][1]); }
    }
};
template <int MODE> struct EpiGate {
    static constexpr bool PERM = true, AFTER_DRAIN = false;
    h16* G1; const h16* G2;
    __device__ __forceinline__ void operator()(const f32x4 (&acc)[2][2][4][2], const Unit& u, int wr, int wc, int fr, int fq) const {
        const int row0 = u.pm * 256 + wr * 64 + fr, col0 = u.pn * 256 + wc * 32 + 8 * fq;
#pragma unroll
        for (int ai = 0; ai < 2; ++ai)
#pragma unroll
            for (int m = 0; m < 4; ++m) { const size_t off = (size_t)(row0 + ai * 128 + m * 16) * 1024 + col0;
#pragma unroll
                for (int bj = 0; bj < 2; ++bj) {
                    const h16x8 g1 = *(const h16x8*)(G1 + off + bj * 128);
                    f32x4 v0 = acc[ai][bj][m][0], v1 = acc[ai][bj][m][1];
                    if (MODE == 0) {
#pragma unroll
                        for (int e = 0; e < 4; ++e) { v0[e] *= (float)g1[e]; v1[e] *= (float)g1[4 + e]; }
                    } else {
                        const h16x8 g2 = *(const h16x8*)(G2 + off + bj * 128);
#pragma unroll
                        for (int e = 0; e < 4; ++e) { v0[e] = (float)g1[e] + (float)g2[e] * v0[e]; v1[e] = (float)g1[4 + e] + (float)g2[4 + e] * v1[e]; }
                    }
                    store8(G1 + off + bj * 128, v0, v1);
                } }
    }
};
}

typedef GAS unsigned gu32;
#define XB_TMO      128
#define XB_XCNT(j)  (256  + 64 * (j))
#define XB_XSUB(j)  (1280 + 64 * (j))
#define XB_XGEN(j)  (2304 + 64 * (j))
#define XB_TOP      3328
#define XB_TOPGEN   3392
#define XCD_BAR_WORDS 3456
#define XB_SPIN_CAP (1u << 18)
__device__ __forceinline__ unsigned xb_ld(unsigned* p)              { return __hip_atomic_load(p, __ATOMIC_RELAXED, __HIP_MEMORY_SCOPE_AGENT); }
__device__ __forceinline__ unsigned xb_add(unsigned* p, unsigned v) { return __hip_atomic_fetch_add(p, v, __ATOMIC_RELAXED, __HIP_MEMORY_SCOPE_AGENT); }
__device__ __forceinline__ unsigned xb_xcc_id() { return (unsigned)__builtin_amdgcn_s_getreg((3 << 11) | 20) & 0xFu; }
#define XB_SPIN(cond, bar) do { unsigned _sp = 0; while (cond) { __builtin_amdgcn_s_sleep(1); \
    if ((++_sp & 255u) == 0u) { if (xb_ld(&(bar)[XB_TMO])) break; if (_sp > XB_SPIN_CAP) { atomicAdd(&(bar)[XB_TMO], 1u); break; } } } } while (0)
struct XcdBarrier { unsigned* bar; unsigned x; volatile LAS unsigned* st; };
__device__ __forceinline__ XcdBarrier xcd_barrier_post(unsigned* bar, volatile LAS unsigned* st) {
    XcdBarrier b; b.bar = bar; b.x = xb_xcc_id(); b.st = st;
    if (threadIdx.x == 0) (void)xb_add(&bar[XB_XCNT(b.x)], 1u);
    return b;
}
__device__ __forceinline__ void xcd_barrier_complete(unsigned* bar, unsigned x, unsigned& nloc, unsigned& nx) {
    const unsigned G = gridDim.x * gridDim.y * gridDim.z;
    unsigned sum, cnt, mine, sp = 0u;
    for (;;) {
        sum = 0u; cnt = 0u; mine = 0u;
#pragma unroll
        for (unsigned j = 0; j < 16; ++j) { const unsigned c = xb_ld(&bar[XB_XCNT(j)]); sum += c; cnt += (c > 0u) ? 1u : 0u; mine = (j == x) ? c : mine; }
        if (sum == G) break;
        __builtin_amdgcn_s_sleep(1);
        if ((++sp & 255u) == 0u) { if (xb_ld(&bar[XB_TMO])) break; if (sp > XB_SPIN_CAP) { atomicAdd(&bar[XB_TMO], 1u); break; } }
    }
    nloc = mine > 0u ? mine : 1u; nx = cnt > 0u ? cnt : 1u;
}
__device__ __forceinline__ void xcd_barrier(const XcdBarrier& b) {
    asm volatile("s_waitcnt vmcnt(0)" ::: "memory");
    __syncthreads();
    if (threadIdx.x == 0) {
        unsigned* bar = b.bar;
        __builtin_amdgcn_s_waitcnt(0);
        unsigned nloc = b.st[0], nx = b.st[1];
        if (nloc == 0u) { xcd_barrier_complete(bar, b.x, nloc, nx); b.st[0] = nloc; b.st[1] = nx; }
        const unsigned old = xb_add(&bar[XB_XSUB(b.x)], 1u);
        const unsigned gen = old / nloc;
        if (old + 1u == (gen + 1u) * nloc) {
            __builtin_amdgcn_fence(__ATOMIC_RELEASE, "agent");
            asm volatile("s_waitcnt vmcnt(0)" ::: "memory");
            const unsigned og = xb_add(&bar[XB_TOP], 1u);
            const unsigned tg = og / nx;
            if (og + 1u == (tg + 1u) * nx) xb_add(&bar[XB_TOPGEN], 1u);
            else XB_SPIN(xb_ld(&bar[XB_TOPGEN]) == tg, bar);
            __builtin_amdgcn_fence(__ATOMIC_ACQUIRE, "agent");
            xb_add(&bar[XB_XGEN(b.x)], 1u);
            asm volatile("s_waitcnt vmcnt(0)" ::: "memory");
        } else {
            XB_SPIN(xb_ld(&bar[XB_XGEN(b.x)]) == gen, bar);
            __builtin_amdgcn_fence(__ATOMIC_ACQUIRE, "agent");
            asm volatile("s_waitcnt vmcnt(0)" ::: "memory");
        }
    }
    __syncthreads();
}

struct Frame {
    LAS unsigned char* lds; int tid, lane, wave, vcu, G;
    const float *x, *g1, *w_in, *bm, *relb, *wa, *wb, *wo, *g2; float* out;
    h16 *WIN, *WA, *WB, *WOUT, *XN, *QA, *KA, *VAT, *GA, *QB, *GB, *GTA, *GTB, *KVB, *IQ, *IK;
    float *IW, *ROPEB, *ROPEI, *BIAS;
};

__device__ __forceinline__ int win_src_col(int j) {
    if (j < 1024) return j;
    if (j < 1536) return 1536 + (j - 1024);
    if (j < 2048) { const int o = j - 1536, hd = o >> 6, p = o & 63; const int lp = p < 16 ? ((p & 1) * 8 + (p >> 1)) : p; return 2048 + hd * 64 + lp; }
    if (j < 2560) return 2688 + (j - 2048);
    if (j < 3584) return 3496 + (j - 2560);
    if (j < 4608) return 4520 + (j - 3584);
    if (j < 5120) { const int o = j - 4608;
        if (o < 64) { const int lp = o < 16 ? ((o & 1) * 8 + (o >> 1)) : o; return 2560 + lp; }
        if (o < 128) return 2624 + (o - 64);
        if (o < 384) { const int q = o - 128, hd = q >> 5, p = q & 31; const int lp = p < 8 ? ((p & 1) * 4 + (p >> 1)) : p; return 3200 + hd * 32 + lp; }
        if (o < 416) { const int p = o - 384; const int lp = p < 8 ? ((p & 1) * 4 + (p >> 1)) : p; return 3456 + lp; }
        if (o < 424) return 3488 + (o - 416);
        return -1; }
    return 1024 + (j - 5120);
}
template <bool MAP> __device__ __forceinline__ void p0_transpose_item(const float* W, int K, int N, h16* WT, LAS float* scr, int item, int lane) {
    const int kblk = K / 64, nb = item / kblk, kb = item % kblk, k0 = 64 * kb, j0 = 32 * nb;
    const int src = MAP ? win_src_col(j0 + (lane & 31)) : (j0 + (lane & 31));
#pragma unroll 8
    for (int i = 0; i < 32; ++i) { const int kk = 2 * i + (lane >> 5); scr[kk * 33 + (lane & 31)] = (src >= 0) ? W[(size_t)(k0 + kk) * N + src] : 0.f; }
    asm volatile("s_waitcnt lgkmcnt(0)" ::: "memory");
    const int c = lane & 7;
#pragma unroll
    for (int j = 0; j < 4; ++j) { const int n = (lane >> 3) + 8 * j; const LAS float* s = scr + (8 * c) * 33 + n;
        u32x4 o; o.x = pkh(s[0 * 33], s[1 * 33]); o.y = pkh(s[2 * 33], s[3 * 33]); o.z = pkh(s[4 * 33], s[5 * 33]); o.w = pkh(s[6 * 33], s[7 * 33]);
        *(u32x4*)(WT + (size_t)(j0 + n) * K + k0 + 8 * c) = o; }
    asm volatile("s_waitcnt lgkmcnt(0)" ::: "memory");
}
__device__ __forceinline__ void sincos_acc(float angf, float& c, float& s) {
    const double a = (double)angf;
    const double k = rint(a * 0.63661977236758134308);
    const double r = (a - k * 1.5707963267948966192) - k * 6.123233995736766e-17;
    const double r2 = r * r;
    const double sp = r * (1.0 + r2 * (-1.0 / 6 + r2 * (1.0 / 120 + r2 * (-1.0 / 5040 + r2 * (1.0 / 362880 + r2 * (-1.0 / 39916800 + r2 * (1.0 / 6227020800.0 + r2 * (-1.0 / 1307674368000.0))))))));
    const double cp = 1.0 + r2 * (-0.5 + r2 * (1.0 / 24 + r2 * (-1.0 / 720 + r2 * (1.0 / 40320 + r2 * (-1.0 / 3628800 + r2 * (1.0 / 479001600.0 + r2 * (-1.0 / 87178291200.0 + r2 * (1.0 / 20922789888000.0))))))));
    const int q = ((int)(long long)k) & 3;
    const double sv = (q == 0) ? sp : (q == 1) ? cp : (q == 2) ? -sp : -cp;
    const double cv = (q == 0) ? cp : (q == 1) ? -sp : (q == 2) ? -cp : sp;
    c = (float)cv; s = (float)sv;
}
__device__ __forceinline__ void p0_prologue(Frame& F) {
    LAS float* scr = (LAS float*)(F.lds + F.wave * 16384);
    const int gw = F.vcu * NWAVES + F.wave, NGW = F.G * NWAVES;
    constexpr int I_IN = (NPHYS / 32) * (DM / 64), I_A = (DM / 32) * (512 / 64), I_O = (DM / 32) * (DM / 64);
    constexpr int NITEMS = I_IN + 2 * I_A + I_O;
    for (int it = gw; it < NITEMS; it += NGW) {
        int r = it;
        if (r < I_IN) { p0_transpose_item<true>(F.w_in, DM, INW, F.WIN, scr, r, F.lane); continue; } r -= I_IN;
        if (r < I_A) { p0_transpose_item<false>(F.wa, 512, DM, F.WA, scr, r, F.lane); continue; } r -= I_A;
        if (r < I_A) { p0_transpose_item<false>(F.wb, 512, DM, F.WB, scr, r, F.lane); continue; } r -= I_A;
        p0_transpose_item<false>(F.wo, DM, DM, F.WOUT, scr, r, F.lane);
    }
    {
        f32x4 gv[4];
#pragma unroll
        for (int j = 0; j < 4; ++j) gv[j] = ((const f32x4*)F.g1)[F.lane + 64 * j];
        for (int m = gw; m < T; m += NGW) {
            const f32x4* xr = (const f32x4*)(F.x + (size_t)m * DM) + F.lane;
            f32x4 v[4]; float s = 0.f;
#pragma unroll
            for (int j = 0; j < 4; ++j) { v[j] = xr[64 * j]; s += (v[j].x * v[j].x + v[j].y * v[j].y) + (v[j].z * v[j].z + v[j].w * v[j].w); }
            const float rs = 1.0f / sqrtf(wave_sum(s) * (1.0f / DM) + EPS);
            u32x2* o8 = (u32x2*)(F.XN + (size_t)m * DM) + F.lane;
#pragma unroll
            for (int j = 0; j < 4; ++j) { const f32x4 y = v[j] * rs * gv[j]; u32x2 w; w.x = pkh(y.x, y.y); w.y = pkh(y.z, y.w); o8[64 * j] = w; }
        }
    }
    const int gt = F.vcu * (NWAVES * 64) + F.tid, NGT = F.G * NWAVES * 64;
    for (int idx = gt; idx < SEQ * 12; idx += NGT) {
        const int pos = idx / 12, e = idx % 12; const int half = e < 8 ? 8 : 4, i = e < 8 ? e : e - 8;
        const float inv = powf(500000.0f, -(float)i / (float)half);
        const float ang = (float)pos * inv; float c, s; sincos_acc(ang, c, s);
        float* dst = e < 8 ? (F.ROPEB + (size_t)pos * 16 + 2 * i) : (F.ROPEI + (size_t)pos * 8 + 2 * i);
        dst[0] = c; dst[1] = s;
    }
    for (int idx = gt; idx < 8 * 513; idx += NGT) F.BIAS[idx] = F.relb[idx] * LOG2E;
}

__device__ __forceinline__ float half_swap_max(float v) { auto rr = __builtin_amdgcn_permlane32_swap(__float_as_uint(v), __float_as_uint(v), false, false); return fmaxf(__uint_as_float(rr[0]), __uint_as_float(rr[1])); }
__device__ __forceinline__ float half_swap_sum(float v) { auto rr = __builtin_amdgcn_permlane32_swap(__float_as_uint(v), __float_as_uint(v), false, false); return __uint_as_float(rr[0]) + __uint_as_float(rr[1]); }
__device__ __forceinline__ void attn_a_unit(const Frame& F, int b, int h, int c, const LAS float* biasL) {
    const int lane = F.lane, r = lane & 31, hh = lane >> 5;
    const size_t tokbase = (size_t)b * SEQ; const int t0 = c * 64;
    const int sig = (r & ~12) | ((r & 4) << 1) | ((r & 8) >> 1);
    h16x8 qf[2][4];
#pragma unroll
    for (int qb = 0; qb < 2; ++qb)
#pragma unroll
        for (int s = 0; s < 4; ++s) qf[qb][s] = *(const h16x8*)(F.QA + (tokbase + t0 + 32 * qb + r) * 512 + h * 64 + 16 * s + 8 * hh);
    f32x16 o[2][2];
#pragma unroll
    for (int a = 0; a < 2; ++a)
#pragma unroll
        for (int q = 0; q < 2; ++q)
#pragma unroll
            for (int e = 0; e < 16; ++e) o[a][q][e] = 0.f;
    float mrun[2] = {-1.0e30f, -1.0e30f}, lrun[2] = {0.f, 0.f};
    const h16* Kb = F.KA + tokbase * 512 + h * 64 + 8 * hh;
    const h16* Vb = F.VAT + (size_t)(h * 64 + r) * T + tokbase + 8 * hh;
    const LAS float* bh = biasL + h * 513;
    const float bfar = bh[512];
    const int kc0 = c > 8 ? c - 8 : 0;
    for (int kc = kc0; kc <= c; ++kc) {
#pragma unroll 1
        for (int half = 0; half < 2; ++half) {
            const int s0 = kc * 64 + 32 * half;
            h16x8 kf[4], vf[2][2];
#pragma unroll
            for (int s = 0; s < 4; ++s) kf[s] = *(const h16x8*)(Kb + (size_t)(s0 + sig) * 512 + 16 * s);
#pragma unroll
            for (int dt = 0; dt < 2; ++dt)
#pragma unroll
                for (int sp = 0; sp < 2; ++sp) vf[dt][sp] = *(const h16x8*)(Vb + (size_t)(32 * dt) * T + s0 + 16 * sp);
            const int delta = t0 - s0;
#pragma unroll
            for (int qb = 0; qb < 2; ++qb) {
                f32x16 S;
#pragma unroll
                for (int e = 0; e < 16; ++e) S[e] = 0.f;
#pragma unroll
                for (int s = 0; s < 4; ++s) S = __builtin_amdgcn_mfma_f32_32x32x16_f16(kf[s], qf[qb][s], S, 0, 0, 0);
                if (delta + 32 * qb >= 288) {
#pragma unroll
                    for (int e = 0; e < 16; ++e) S[e] += bfar;
                } else {
                    const int D0 = delta + 32 * qb + r - 8 * hh + 256;
#pragma unroll
                    for (int e = 0; e < 16; ++e) { const int kr = (e & 3) + 4 * ((e >> 2) & 1) + 16 * (e >> 3); int di = D0 - kr; di = di > 512 ? 512 : di; S[e] += bh[di]; }
                }
                float tm = S[0];
#pragma unroll
                for (int e = 1; e < 16; ++e) tm = fmaxf(tm, S[e]);
                tm = half_swap_max(tm);
                const float mnew = fmaxf(mrun[qb], tm), alpha = fexp2(mrun[qb] - mnew);
                mrun[qb] = mnew;
                float ps = 0.f;
#pragma unroll
                for (int e = 0; e < 16; ++e) { S[e] = fexp2(S[e] - mnew); ps += S[e]; }
                lrun[qb] = lrun[qb] * alpha + ps;
#pragma unroll
                for (int dt = 0; dt < 2; ++dt)
#pragma unroll
                    for (int e = 0; e < 16; ++e) o[dt][qb][e] *= alpha;
                u32x4 pw[2];
#pragma unroll
                for (int sp = 0; sp < 2; ++sp) { pw[sp].x = pkh(S[8 * sp + 0], S[8 * sp + 1]); pw[sp].y = pkh(S[8 * sp + 2], S[8 * sp + 3]); pw[sp].z = pkh(S[8 * sp + 4], S[8 * sp + 5]); pw[sp].w = pkh(S[8 * sp + 6], S[8 * sp + 7]); }
#pragma unroll
                for (int dt = 0; dt < 2; ++dt)
#pragma unroll
                    for (int sp = 0; sp < 2; ++sp) o[dt][qb] = __builtin_amdgcn_mfma_f32_32x32x16_f16(vf[dt][sp], __builtin_bit_cast(h16x8, pw[sp]), o[dt][qb], 0, 0, 0);
            }
        }
    }
#pragma unroll
    for (int qb = 0; qb < 2; ++qb) {
        const float inv = 1.0f / half_swap_sum(lrun[qb]);
        const size_t rowoff = (tokbase + t0 + 32 * qb + r) * 512 + h * 64;
#pragma unroll
        for (int dt = 0; dt < 2; ++dt)
#pragma unroll
            for (int g4 = 0; g4 < 4; ++g4) {
                const int d0 = 32 * dt + 8 * g4 + 4 * hh;
                const h16x4 ga = *(const h16x4*)(F.GA + rowoff + d0);
                u32x2 w; w.x = pkh(o[dt][qb][4 * g4 + 0] * inv * (float)ga[0], o[dt][qb][4 * g4 + 1] * inv * (float)ga[1]);
                w.y = pkh(o[dt][qb][4 * g4 + 2] * inv * (float)ga[2], o[dt][qb][4 * g4 + 3] * inv * (float)ga[3]);
                *(u32x2*)(F.QA + rowoff + d0) = w;
            }
    }
}

__device__ __forceinline__ unsigned fkey(float f) { const unsigned u = __float_as_uint(f); return (u & 0x80000000u) ? ~u : (u | 0x80000000u); }
__device__ __forceinline__ unsigned mbcnt64(unsigned long long m) { return __builtin_amdgcn_mbcnt_hi((unsigned)(m >> 32), __builtin_amdgcn_mbcnt_lo((unsigned)m, 0u)); }
__device__ __forceinline__ void dsa_unit(const Frame& F, int b, int qg) {
    const int lane = F.lane, wave = F.wave;
    const size_t tokbase = (size_t)b * SEQ; const int t0 = qg * 8, c = t0 >> 6, n = (c + 1) * 64;
    LAS float* scores = (LAS float*)F.lds;
    LAS float* row = scores + wave * 4096;
    LAS unsigned* hist = (LAS unsigned*)(F.lds + LDS_HIST) + wave * 512;
    LAS unsigned short* idxl = (LAS unsigned short*)(F.lds + LDS_IDX) + wave * 256;
    int nsel;
    if (n > 256) {
        {
            const int q = lane & 7, hs = (lane >> 3) & 1, g = lane >> 4;
            h16x8 bq[4]; float w[4];
#pragma unroll
            for (int hp = 0; hp < 4; ++hp) { bq[hp] = *(const h16x8*)(F.IQ + (tokbase + t0 + q) * 256 + (2 * hp + hs) * 32 + 8 * g); w[hp] = F.IW[(tokbase + t0 + q) * 8 + 2 * hp + hs]; }
            const int ntile = n >> 4;
            for (int tile = wave; tile < ntile; tile += NWAVES) {
                const h16x8 ak = *(const h16x8*)(F.IK + (tokbase + 16 * tile + (lane & 15)) * 32 + 8 * g);
                f32x4 acc = {0.f, 0.f, 0.f, 0.f};
#pragma unroll
                for (int hp = 0; hp < 4; ++hp) {
                    f32x4 cz = {0.f, 0.f, 0.f, 0.f};
                    cz = __builtin_amdgcn_mfma_f32_16x16x32_f16(ak, bq[hp], cz, 0, 0, 0);
#pragma unroll
                    for (int e = 0; e < 4; ++e) acc[e] += fmaxf(cz[e], 0.f) * w[hp];
                }
#pragma unroll
                for (int e = 0; e < 4; ++e) acc[e] += __shfl_xor(acc[e], 8);
                if (hs == 0) *(LAS f32x4*)(scores + q * 4096 + 16 * tile + 4 * g) = acc;
            }
        }
        __syncthreads();
        const int nslot = n >> 6;
        float mn = 3.0e38f, mx = -3.0e38f;
        for (int i = 0; i < nslot; ++i) { const float v = row[i * 64 + lane]; mn = fminf(mn, v); mx = fmaxf(mx, v); }
        mn = wave_min(mn); mx = wave_max(mx);
        const float range = mx - mn; const float scale = range > 0.f ? fminf(512.0f / range, 3.0e38f) : 0.f;
        ((LAS u32x4*)hist)[lane * 2] = (u32x4){0u, 0u, 0u, 0u}; ((LAS u32x4*)hist)[lane * 2 + 1] = (u32x4){0u, 0u, 0u, 0u};
        asm volatile("s_waitcnt lgkmcnt(0)" ::: "memory");
        for (int i = 0; i < nslot; ++i) { const float v = row[i * 64 + lane]; int bn = (int)((v - mn) * scale); bn = bn > 511 ? 511 : bn;
            __hip_atomic_fetch_add(hist + bn, 1u, __ATOMIC_RELAXED, __HIP_MEMORY_SCOPE_WORKGROUP); }
        asm volatile("s_waitcnt lgkmcnt(0)" ::: "memory");
        int bstar; unsigned above;
        {
            const u32x4 h0 = ((LAS u32x4*)hist)[lane * 2], h1 = ((LAS u32x4*)hist)[lane * 2 + 1];
            const unsigned hb[8] = {h0.x, h0.y, h0.z, h0.w, h1.x, h1.y, h1.z, h1.w};
            const unsigned s = (h0.x + h0.y) + (h0.z + h0.w) + (h1.x + h1.y) + (h1.z + h1.w);
            unsigned Tl = s;
#pragma unroll
            for (int d = 1; d < 64; d <<= 1) { const unsigned o2 = __shfl_down(Tl, d); if (lane + d < 64) Tl += o2; }
            const unsigned long long bal = __ballot(Tl >= 256u);
            const int L = __popcll(bal) - 1;
            unsigned cab = Tl - s; int bst = 0; unsigned ab = 0; bool found = false;
#pragma unroll
            for (int j = 7; j >= 0; --j) { if (!found) { if (cab + hb[j] >= 256u) { bst = 8 * lane + j; ab = cab; found = true; } else cab += hb[j]; } }
            bstar = __builtin_amdgcn_readlane(bst, L); above = (unsigned)__builtin_amdgcn_readlane((int)ab, L);
        }
        const unsigned need = 256u - above;
        LAS float* candv = (LAS float*)hist; LAS unsigned short* candi = (LAS unsigned short*)(hist + 64);
        unsigned base = 0, m = 0;
        for (int i = 0; i < nslot; ++i) {
            const float v = row[i * 64 + lane]; int bn = (int)((v - mn) * scale); bn = bn > 511 ? 511 : bn;
            const bool sel = bn > bstar, cand = bn == bstar;
            const unsigned long long ms = __ballot(sel);
            if (sel) idxl[base + mbcnt64(ms)] = (unsigned short)(i * 64 + lane);
            base += (unsigned)__popcll(ms);
            const unsigned long long mc = __ballot(cand);
            if (mc) { if (cand) { const unsigned p = m + mbcnt64(mc); if (p < 64u) { candv[p] = v; candi[p] = (unsigned short)(i * 64 + lane); } } m += (unsigned)__popcll(mc); }
        }
        asm volatile("s_waitcnt lgkmcnt(0)" ::: "memory");
        if (m <= 64u) {
            const float cv = (unsigned)lane < m ? candv[lane] : 0.f; unsigned rank = 0;
            for (unsigned k = 0; k < m; ++k) { const float vk = candv[k]; rank += (vk > cv || (vk == cv && k < (unsigned)lane)) ? 1u : 0u; }
            const bool win = (unsigned)lane < m && rank < need;
            const unsigned long long mw = __ballot(win);
            if (win) idxl[base + mbcnt64(mw)] = candi[lane];
        } else {
            unsigned cur = 0;
            for (int bit = 31; bit >= 0; --bit) { const unsigned trial = cur | (1u << bit); unsigned cnt = 0;
                for (int i = 0; i < nslot; ++i) cnt += fkey(row[i * 64 + lane]) >= trial ? 1u : 0u;
                cnt = wave_sum_u(cnt); if (cnt >= 256u) cur = trial; }
            unsigned cgt = 0;
            for (int i = 0; i < nslot; ++i) cgt += fkey(row[i * 64 + lane]) > cur ? 1u : 0u;
            cgt = wave_sum_u(cgt);
            const unsigned needt = 256u - cgt; unsigned bs = 0, seen = 0;
            for (int i = 0; i < nslot; ++i) { const unsigned k = fkey(row[i * 64 + lane]); const bool eq = k == cur;
                const unsigned long long me = __ballot(eq); const bool take = k > cur || (eq && seen + mbcnt64(me) < needt);
                const unsigned long long mt = __ballot(take);
                if (take) idxl[bs + mbcnt64(mt)] = (unsigned short)(i * 64 + lane);
                bs += (unsigned)__popcll(mt); seen += (unsigned)__popcll(me); }
        }
        nsel = 256;
    } else {
        nsel = n;
#pragma unroll
        for (int i = 0; i < 4; ++i) if (i * 64 < n) idxl[i * 64 + lane] = (unsigned short)(i * 64 + lane);
    }
    asm volatile("s_waitcnt lgkmcnt(0)" ::: "memory");
    {
        const int col = lane & 15, g = lane >> 4; const size_t tok = tokbase + t0 + wave;
        h16x8 qf[2];
#pragma unroll
        for (int s = 0; s < 2; ++s) { if (col < 8) qf[s] = *(const h16x8*)(F.QB + tok * 512 + col * 64 + 32 * s + 8 * g); else { qf[s] = (h16x8){0, 0, 0, 0, 0, 0, 0, 0}; } }
        const int ntile = nsel >> 4;
        f32x4 S[16];
#pragma unroll
        for (int tt = 0; tt < 16; ++tt) {
            S[tt] = (f32x4){0.f, 0.f, 0.f, 0.f};
            if (tt < ntile) {
                const int kidx = idxl[16 * tt + col];
                const h16* kp = F.KVB + (tokbase + kidx) * 128 + 8 * g;
                const h16x8 a0 = *(const h16x8*)kp, a1 = *(const h16x8*)(kp + 32);
                S[tt] = __builtin_amdgcn_mfma_f32_16x16x32_f16(a0, qf[0], S[tt], 0, 0, 0);
                S[tt] = __builtin_amdgcn_mfma_f32_16x16x32_f16(a1, qf[1], S[tt], 0, 0, 0);
            }
        }
        float mxv = -3.0e38f;
#pragma unroll
        for (int tt = 0; tt < 16; ++tt) if (tt < ntile) mxv = fmaxf(fmaxf(mxv, fmaxf(S[tt][0], S[tt][1])), fmaxf(S[tt][2], S[tt][3]));
        mxv = fmaxf(mxv, __shfl_xor(mxv, 16)); mxv = fmaxf(mxv, __shfl_xor(mxv, 32));
        float ls = 0.f;
#pragma unroll
        for (int tt = 0; tt < 16; ++tt) {
            if (tt < ntile) {
#pragma unroll
                for (int e = 0; e < 4; ++e) { S[tt][e] = fexp2(S[tt][e] - mxv); ls += S[tt][e]; }
            } else S[tt] = (f32x4){0.f, 0.f, 0.f, 0.f};
        }
        ls += __shfl_xor(ls, 16); ls += __shfl_xor(ls, 32);
        const float inv = 1.0f / ls;
        f32x4 O[4];
#pragma unroll
        for (int dt = 0; dt < 4; ++dt) O[dt] = (f32x4){0.f, 0.f, 0.f, 0.f};
        LAS unsigned char* vst = (LAS unsigned char*)row;
        constexpr int VROW = 160;
        const int npiece = nsel >> 6;
#pragma unroll
        for (int pc = 0; pc < 4; ++pc) {
            if (pc < npiece) {
#pragma unroll
                for (int i = 0; i < 8; ++i) {
                    const int rr = 8 * i + (lane >> 3); const int kidx = idxl[64 * pc + rr];
                    const u32x4 v = *(const u32x4*)(F.KVB + (tokbase + kidx) * 128 + 64 + 8 * (lane & 7));
                    *(LAS u32x4*)(vst + rr * VROW + 16 * (lane & 7)) = v;
                }
                asm volatile("s_waitcnt lgkmcnt(0)" ::: "memory");
#pragma unroll
                for (int kh = 0; kh < 2; ++kh) {
                    const int ks = 2 * pc + kh;
                    u32x4 pw; pw.x = pkh(S[2 * ks][0], S[2 * ks][1]); pw.y = pkh(S[2 * ks][2], S[2 * ks][3]); pw.z = pkh(S[2 * ks + 1][0], S[2 * ks + 1][1]); pw.w = pkh(S[2 * ks + 1][2], S[2 * ks + 1][3]);
                    const h16x8 pb = __builtin_bit_cast(h16x8, pw);
                    const int i16 = lane & 15, qq = i16 >> 2, pp = i16 & 3;
                    const LAS unsigned char* rb = vst + (32 * kh + 4 * g + qq) * VROW + 8 * pp;
#pragma unroll
                    for (int dt = 0; dt < 4; ++dt) {
                        const s16x4 lo = __builtin_amdgcn_ds_read_tr16_b64_v4i16((LAS s16x4*)(rb + 32 * dt));
                        const s16x4 hi = __builtin_amdgcn_ds_read_tr16_b64_v4i16((LAS s16x4*)(rb + 16 * VROW + 32 * dt));
                        const h16x8 av = __builtin_bit_cast(h16x8, (__attribute__((ext_vector_type(8))) short){lo[0], lo[1], lo[2], lo[3], hi[0], hi[1], hi[2], hi[3]});
                        O[dt] = __builtin_amdgcn_mfma_f32_16x16x32_f16(av, pb, O[dt], 0, 0, 0);
                    }
                }
                asm volatile("s_waitcnt lgkmcnt(0)" ::: "memory");
            }
        }
        if (col < 8) {
#pragma unroll
            for (int dt = 0; dt < 4; ++dt) {
                const size_t off = tok * 512 + col * 64 + 16 * dt + 4 * g;
                const h16x4 gb = *(const h16x4*)(F.GB + off);
                u32x2 w; w.x = pkh(O[dt][0] * inv * (float)gb[0], O[dt][1] * inv * (float)gb[1]); w.y = pkh(O[dt][2] * inv * (float)gb[2], O[dt][3] * inv * (float)gb[3]);
                *(u32x2*)(F.QB + off) = w;
            }
        }
    }
    __syncthreads();
}

__device__ __forceinline__ void p2_mixers(Frame& F) {
    LAS float* biasL = (LAS float*)F.lds;
    for (int i = F.tid; i < 8 * 513; i += NWAVES * 64) biasL[i] = F.BIAS[i];
    __syncthreads();
    for (int wu = F.vcu; wu < NBATCH * 8 * 8; wu += F.G) {
        const int b = wu >> 6, h = (wu >> 3) & 7, cg = wu & 7;
        attn_a_unit(F, b, h, cg * 8 + F.wave, biasL);
    }
    __syncthreads();
    const int NU = T / 8;
    for (int i = 0; i * F.G < NU; ++i) {
        const int cu = (i & 1) ? (F.G - 1 - F.vcu) : F.vcu;
        const int u = i * F.G + cu; if (u >= NU) break;
        const int b = u & 7, qg = u >> 3;
        dsa_unit(F, b, qg);
    }
}

__device__ __forceinline__ void p3_final(Frame& F, const h16* Y3) {
    const int gw = F.vcu * NWAVES + F.wave, NGW = F.G * NWAVES;
    f32x4 gv[4];
#pragma unroll
    for (int j = 0; j < 4; ++j) gv[j] = ((const f32x4*)F.g2)[F.lane + 64 * j];
    for (int m = gw; m < T; m += NGW) {
        const f32x4* xr = (const f32x4*)(F.x + (size_t)m * DM) + F.lane;
        const u32x2* yr = (const u32x2*)(Y3 + (size_t)m * DM) + F.lane;
        f32x4 v[4]; float s = 0.f;
#pragma unroll
        for (int j = 0; j < 4; ++j) { v[j] = xr[64 * j]; const h16x4 y = __builtin_bit_cast(h16x4, yr[64 * j]);
            v[j].x += (float)y[0]; v[j].y += (float)y[1]; v[j].z += (float)y[2]; v[j].w += (float)y[3];
            s += (v[j].x * v[j].x + v[j].y * v[j].y) + (v[j].z * v[j].z + v[j].w * v[j].w); }
        const float rs = 1.0f / sqrtf(wave_sum(s) * (1.0f / DM) + EPS);
        f32x4* orow = (f32x4*)(F.out + (size_t)m * DM) + F.lane;
#pragma unroll
        for (int j = 0; j < 4; ++j) orow[64 * j] = v[j] * rs * gv[j];
    }
}

struct Args { const float* in[9]; float* out; unsigned char* ws; int ph_lo, ph_hi, li, pad; };
__global__ void __launch_bounds__(NWAVES * 64, 2) hybrid_fwd(Args args) {
    extern __shared__ __attribute__((aligned(16))) unsigned char lds[];
    Frame F;
    F.lds = (LAS unsigned char*)lds;
    F.tid = threadIdx.x; F.lane = F.tid & 63; F.wave = __builtin_amdgcn_readfirstlane(F.tid >> 6);
    F.G = gridDim.x; { const int bx = blockIdx.x; F.vcu = (F.G % 8 == 0) ? (bx % 8) * (F.G / 8) + bx / 8 : bx; }
    unsigned char* ws = args.ws;
    F.x = args.in[0]; F.g1 = args.in[1]; F.w_in = args.in[2]; F.bm = args.in[3]; F.relb = args.in[4]; F.wa = args.in[5]; F.wb = args.in[6]; F.wo = args.in[7]; F.g2 = args.in[8]; F.out = args.out;
    F.WIN = (h16*)(ws + WS_WIN); F.WA = (h16*)(ws + WS_WA); F.WB = (h16*)(ws + WS_WB); F.WOUT = (h16*)(ws + WS_WOUT);
    F.XN = (h16*)(ws + WS_XN); F.QA = (h16*)(ws + WS_QA); F.KA = (h16*)(ws + WS_KA); F.VAT = (h16*)(ws + WS_VAT); F.GA = (h16*)(ws + WS_GA); F.QB = (h16*)(ws + WS_QB); F.GB = (h16*)(ws + WS_GB);
    F.GTA = (h16*)(ws + WS_GTA); F.GTB = (h16*)(ws + WS_GTB); F.KVB = (h16*)(ws + WS_KVB); F.IQ = (h16*)(ws + WS_IQ); F.IK = (h16*)(ws + WS_IK);
    F.IW = (float*)(ws + WS_IW); F.ROPEB = (float*)(ws + WS_ROPEB); F.ROPEI = (float*)(ws + WS_ROPEI); F.BIAS = (float*)(ws + WS_BIAS);
    for (int u = F.tid; u < (LDS_BYTES - LDSCTL_OFF) / 4; u += NWAVES * 64) ((LAS unsigned*)(F.lds + LDSCTL_OFF))[u] = 0u;
    __syncthreads();
    volatile LAS unsigned* MISC = (volatile LAS unsigned*)(F.lds + MISC_OFF);
    unsigned* barw = (unsigned*)(ws + WS_CTL) + CW_BAR + args.li * XCD_BAR_WORDS;
    XcdBarrier bar; bar.bar = barw; bar.x = 0; bar.st = nullptr;
    if (N_LAUNCHES != PER_PHASE) bar = xcd_barrier_post(barw, MISC + 8);
#define GRID_BAR() do { if (N_LAUNCHES != PER_PHASE) xcd_barrier(bar); } while (0)
    const int lo = args.ph_lo, hi = args.ph_hi;
#define IN(k) (lo <= (k) && (k) < hi)
#define BOTH(k) (IN(k) && IN((k) + 1))
    typedef const unsigned short* cbp;
    if (IN(0)) { p0_prologue(F); if (BOTH(0)) GRID_BAR(); }
    if (IN(1)) {
        {
            pg8::Gemm g{(cbp)F.XN, (cbp)F.WIN, T, NMAIN, DM}; pg8::StaticOrder S; S.init(T, NMAIN, F.G, (int)blockIdx.x);
            epi::EpiProj E{F.QA, F.KA, F.GA, F.QB, F.GB, F.GTA, F.GTB, F.KVB, F.IQ, F.IK, F.IW, F.bm, F.ROPEB, F.ROPEI};
            pg8::gemm_phase<epi::EpiProj, pg8::StaticOrder, true, true>(F.lds, g, S, E);
        }
        {
            pg8::Gemm g{(cbp)(F.WIN + (size_t)NMAIN * DM), (cbp)F.XN, 512, T, DM}; pg8::StaticOrder S; S.init(512, T, F.G, (int)blockIdx.x);
            epi::EpiPlain E{F.VAT, T};
            pg8::gemm_phase<epi::EpiPlain, pg8::StaticOrder, true, true>(F.lds, g, S, E);
        }
        if (BOTH(1)) GRID_BAR();
    }
    if (IN(2)) { p2_mixers(F); if (BOTH(2)) GRID_BAR(); }
    if (IN(3)) {
        {
            pg8::Gemm g{(cbp)F.QA, (cbp)F.WA, T, DM, 512}; pg8::StaticOrder S; S.init(T, DM, F.G, (int)blockIdx.x);
            epi::EpiGate<0> E{F.GTA, nullptr};
            pg8::gemm_phase<epi::EpiGate<0>, pg8::StaticOrder, true, true>(F.lds, g, S, E);
        }
        {
            pg8::Gemm g{(cbp)F.QB, (cbp)F.WB, T, DM, 512}; pg8::StaticOrder S; S.init(T, DM, F.G, (int)blockIdx.x);
            epi::EpiGate<1> E{F.GTA, F.GTB};
            pg8::gemm_phase<epi::EpiGate<1>, pg8::StaticOrder, true, true>(F.lds, g, S, E);
        }
        if (BOTH(3)) GRID_BAR();
    }
    if (IN(4)) {
        pg8::Gemm g{(cbp)F.GTA, (cbp)F.WOUT, T, DM, DM}; pg8::StaticOrder S; S.init(T, DM, F.G, (int)blockIdx.x);
        epi::EpiPlain E{F.XN, DM};
        pg8::gemm_phase<epi::EpiPlain, pg8::StaticOrder, true, true>(F.lds, g, S, E);
        if (BOTH(4)) GRID_BAR();
    }
    if (IN(5)) p3_final(F, F.XN);
#undef IN
#undef BOTH
}

extern "C" void kernel_launch(void* const* d_in, const int* in_sizes, int n_in, void* d_out, int out_size, void* d_ws, size_t ws_size, hipStream_t stream) {
    static int grid = 0;
    if (grid == 0) {
        if (n_in != 9 || in_sizes[0] != T * DM || out_size != T * DM || ws_size < WS_END) { fprintf(stderr, "kernel_launch: unexpected shapes / workspace (n_in %d, in0 %d, out %d, ws %zu)\n", n_in, n_in > 0 ? in_sizes[0] : -1, out_size, ws_size); grid = -1; return; }
        int dev = 0, cus = 0, per_cu = 0;
        if (hipGetDevice(&dev) != hipSuccess || hipDeviceGetAttribute(&cus, hipDeviceAttributeMultiprocessorCount, dev) != hipSuccess) { fprintf(stderr, "kernel_launch: device query failed\n"); grid = -1; return; }
        if (hipFuncSetAttribute((const void*)hybrid_fwd, hipFuncAttributeMaxDynamicSharedMemorySize, LDS_BYTES) != hipSuccess) { fprintf(stderr, "kernel_launch: hipFuncSetAttribute failed\n"); grid = -1; return; }
        if (hipOccupancyMaxActiveBlocksPerMultiprocessor(&per_cu, (const void*)hybrid_fwd, NWAVES * 64, LDS_BYTES) != hipSuccess || per_cu < 1)
            fprintf(stderr, "kernel_launch: note: occupancy query reports %d workgroups per CU\n", per_cu);
        (void)hipGetLastError();
        grid = cus;
    }
    if (grid < 0) return;
    if (hipMemsetAsync((char*)d_ws + WS_CTL, 0, CTL_ZERO_BYTES, stream) != hipSuccess) { fprintf(stderr, "kernel_launch: memset failed\n"); return; }
    Args a{};
    for (int i = 0; i < 9; ++i) a.in[i] = (const float*)d_in[i];
    a.out = (float*)d_out; a.ws = (unsigned char*)d_ws;
    if (N_LAUNCHES == PER_PHASE) {
        for (int li = 0; li < PER_PHASE; ++li) { a.ph_lo = li; a.ph_hi = li + 1; a.li = 0; hipLaunchKernelGGL(hybrid_fwd, dim3(grid), dim3(NWAVES * 64), LDS_BYTES, stream, a); }
    } else {
        a.ph_lo = 0; a.ph_hi = PER_PHASE; a.li = 0;
        hipLaunchKernelGGL(hybrid_fwd, dim3(grid), dim3(NWAVES * 64), LDS_BYTES, stream, a);
    }
    const hipError_t le = hipPeekAtLastError();
    if (le != hipSuccess) fprintf(stderr, "kernel_launch: launch failed: %s\n", hipGetErrorName(le));
}
```

```cpp
#include <hip/hip_runtime.h>
#include <cstdio>
#include <cstdint>

#ifndef REP_PHASE
#define REP_PHASE -1
#endif
#ifndef DIAG_SEL
#define DIAG_SEL -1
#endif
#define DIL_BEGIN(k) const unsigned long long dil_t0_##k = (DIAG_SEL == (k)) ? __builtin_amdgcn_s_memrealtime() : 0ull
#define DIL_END(k) do { if (DIAG_SEL == (k)) { const unsigned long long t1_ = __builtin_amdgcn_s_memrealtime(); const unsigned long long dt_ = t1_ - dil_t0_##k; \
    while (__builtin_amdgcn_s_memrealtime() - t1_ < dt_) __builtin_amdgcn_s_sleep(2); } } while (0)
namespace pg8 {
#define PG8_LAS __attribute__((address_space(3)))
typedef unsigned short bf16_t;
typedef _Float16 bf16x8 __attribute__((ext_vector_type(8)));
typedef float f32x4 __attribute__((ext_vector_type(4)));
typedef unsigned u32x4 __attribute__((ext_vector_type(4)));
constexpr int BM = 256, BK = 64, HALF = 128, HTB = HALF * BK * 2  , STAGE_BYTES = 8 * HTB, NXCD = 8, WGM = 8;

__host__ __device__ __forceinline__ int lds_byte(int r, int c) { const int st = (r >> 4) * 2 + (c >> 5), rr = r & 15, cc = c & 31, ob = rr * 64 + cc * 2; return st * 1024 + (ob ^ (((ob >> 9) & 1) << 5)); }
__host__ __device__ __forceinline__ void stage_rc(int b, int& R, int& C) { const int st = b / 1024, sb = b % 1024, swz = sb ^ (((sb >> 9) & 1) << 5); R = (st >> 1) * 16 + swz / 64; C = (st & 1) * 32 + (swz % 64) / 2; }
__host__ __device__ __forceinline__ int perm32(int rho) { const int n = rho >> 4, i = rho & 15; return 8 * (i >> 2) + 4 * n + (i & 3); }

struct Unit { int pm, pn; };
struct Gemm { const bf16_t* A; const bf16_t* Bt; int M, N, K; };

struct StaticOrder {
    int nM, nN, nwg, G, c;
    __host__ __device__ void init(int M, int N, int G_, int c_) { nM = M / BM; nN = N / BM; nwg = nM * nN; G = G_; c = c_; }
    __host__ __device__ bool next(int i, Unit& u) const {
        const long L = (long)i * G + c; if (L >= nwg) return false;
        int wgid = (int)L; { const int q = nwg / NXCD, r = nwg % NXCD, xcd = wgid % NXCD, off = wgid / NXCD; wgid = (xcd < r ? xcd * (q + 1) : r * (q + 1) + (xcd - r) * q) + off; }
        const int nig = WGM * nN, gid = wgid / nig, fm = gid * WGM, gsz = (nM - fm) < WGM ? (nM - fm) : WGM;
        u.pm = fm + ((wgid % nig) % gsz); u.pn = (wgid % nig) / gsz; return true;
    }
    __device__ __forceinline__ void a_ready(const Unit&) const {}
    __device__ __forceinline__ void done(const Unit&) const {}
};


template <class Epi, class Sched, bool ALIGN_EPI = false, bool SP2 = false>
__device__ __forceinline__ void gemm_phase(PG8_LAS unsigned char* lds, const Gemm g, const Sched& S, const Epi& E) {
    const int tid = threadIdx.x, wid = __builtin_amdgcn_readfirstlane(tid >> 6), lane = tid & 63, wr = wid >> 2, wc = wid & 3, fr = lane & 15, fq = lane >> 4;
    const int K = g.K, nt = K / BK;
    unsigned voffA[2], voffB[2];
#pragma unroll
    for (int i = 0; i < 2; ++i) { int R, C; stage_rc(tid * 16 + i * 8192, R, C); const int Rb = Epi::PERM ? ((R & ~31) + perm32(R & 31)) : R;
        voffA[i] = (unsigned)(R * K + C) * 2u; voffB[i] = (unsigned)(Rb * K + C) * 2u; }
    const size_t kstep = (size_t)(BK * 2);
    const size_t hstep = (size_t)HALF * K * 2;
    const size_t tstep = 2 * hstep;
    const unsigned ldsw = (unsigned)wid * 1024u;
    const int aoff = lds_byte(wr * 64 + fr, fq * 8), boff = lds_byte(wc * 32 + fr, fq * 8);
#define PG8_SA(b, h) (((b) * 2 + (h)) * HTB)
#define PG8_SB(b, h) ((4 + (b) * 2 + (h)) * HTB)
#define PG8_STAGE(bufoff, gbase, voff) do { _Pragma("unroll") for (int _i = 0; _i < 2; ++_i) \
        __builtin_amdgcn_global_load_lds((const unsigned*)((const char*)(gbase) + (voff)[_i]), (PG8_LAS unsigned*)(lds + (bufoff) + ldsw + _i * 8192), 16, 0, 0); } while (0)
#define PG8_LDA(dst, b, h) do { _Pragma("unroll") for (int m = 0; m < 4; ++m) _Pragma("unroll") for (int k = 0; k < 2; ++k) dst[m][k] = *(const PG8_LAS bf16x8*)(lds + PG8_SA(b, h) + aoff + m * 2048 + k * 1024); } while (0)
#define PG8_LDB(dst, b, h) do { _Pragma("unroll") for (int n = 0; n < 2; ++n) _Pragma("unroll") for (int k = 0; k < 2; ++k) dst[n][k] = *(const PG8_LAS bf16x8*)(lds + PG8_SB(b, h) + boff + n * 2048 + k * 1024); } while (0)
#define PG8_MMA(ai, bj, At, Bt) do { __builtin_amdgcn_s_setprio(1); _Pragma("unroll") for (int m = 0; m < 4; ++m) _Pragma("unroll") for (int n = 0; n < 2; ++n) _Pragma("unroll") for (int k = 0; k < 2; ++k) \
        acc[ai][bj][m][n] = __builtin_amdgcn_mfma_f32_16x16x32_f16(Bt[n][k], At[m][k], acc[ai][bj][m][n], 0, 0, 0); __builtin_amdgcn_s_setprio(0); } while (0)
#define PG8_WAIT_V(n) asm volatile("s_waitcnt vmcnt(" #n ")" ::: "memory")
#define PG8_WAIT_L(n) asm volatile("s_waitcnt lgkmcnt(" #n ")" ::: "memory")
#define PG8_BAR __builtin_amdgcn_s_barrier()
#define PG8_SCHED __builtin_amdgcn_sched_barrier(0)
    Unit cur, nxt; int ui = 0;
    if (!S.next(0, cur)) return;
    f32x4 acc[2][2][4][2];
#pragma unroll
    for (int a = 0; a < 2; ++a)
#pragma unroll
        for (int b = 0; b < 2; ++b)
#pragma unroll
            for (int m = 0; m < 4; ++m)
#pragma unroll
                for (int n = 0; n < 2; ++n) acc[a][b][m][n] = (f32x4){0.f, 0.f, 0.f, 0.f};
    bf16x8 At[4][2], B0[2][2], B1[2][2];
    const char* cA = (const char*)g.A + (size_t)cur.pm * tstep; const char* cB = (const char*)g.Bt + (size_t)cur.pn * tstep;
    S.a_ready(cur);
    if constexpr (SP2) {
        PG8_STAGE(PG8_SB(0, 0), cB, voffB); PG8_STAGE(PG8_SB(0, 1), cB + hstep, voffB); PG8_STAGE(PG8_SA(0, 0), cA, voffA); PG8_STAGE(PG8_SA(0, 1), cA + hstep, voffA);
        if (wr == 1) PG8_BAR;
        PG8_WAIT_V(2); PG8_BAR;
        PG8_STAGE(PG8_SB(1, 0), cB + kstep, voffB); PG8_STAGE(PG8_SA(1, 0), cA + kstep, voffA); PG8_STAGE(PG8_SB(1, 1), cB + hstep + kstep, voffB);
        PG8_WAIT_V(6); PG8_BAR;
    } else {
        PG8_STAGE(PG8_SB(0, 0), cB, voffB); PG8_STAGE(PG8_SA(0, 0), cA, voffA); PG8_STAGE(PG8_SB(0, 1), cB + hstep, voffB); PG8_STAGE(PG8_SA(0, 1), cA + hstep, voffA);
        if (wr == 1) PG8_BAR;
        PG8_WAIT_V(4); PG8_BAR;
        PG8_STAGE(PG8_SB(1, 0), cB + kstep, voffB); PG8_STAGE(PG8_SA(1, 0), cA + kstep, voffA); PG8_STAGE(PG8_SB(1, 1), cB + hstep + kstep, voffB);
        PG8_WAIT_V(6); PG8_BAR;
    }
    for (;;) {
        const bool has_next = S.next(ui + 1, nxt);
        const char* nA = has_next ? (const char*)g.A + (size_t)nxt.pm * tstep : cA; const char* nB = has_next ? (const char*)g.Bt + (size_t)nxt.pn * tstep : cB;
        for (int t = 0; t < nt; t += 2) {
            const bool last = (t == nt - 2);
            const char* a1 = cA + (size_t)(t + 1) * kstep;
            const char* a2 = last ? nA : cA + (size_t)(t + 2) * kstep; const char* b2 = last ? nB : cB + (size_t)(t + 2) * kstep;
            const char* a3 = a2 + kstep; const char* b3 = b2 + kstep;
            if (last && has_next) S.a_ready(nxt);
            if constexpr (SP2) {
            PG8_LDB(B0, 0, 0); PG8_LDB(B1, 0, 1); PG8_SCHED; PG8_LDA(At, 0, 0); PG8_STAGE(PG8_SA(1, 1), a1 + hstep, voffA);
            PG8_WAIT_V(8); PG8_WAIT_L(0); PG8_BAR; PG8_MMA(0, 0, At, B0); PG8_MMA(0, 1, At, B1); PG8_BAR; PG8_SCHED;
            PG8_LDA(At, 0, 1); PG8_STAGE(PG8_SB(0, 0), b2, voffB); PG8_STAGE(PG8_SB(0, 1), b2 + hstep, voffB); PG8_STAGE(PG8_SA(0, 0), a2, voffA);
            PG8_WAIT_V(8); PG8_WAIT_L(0); PG8_BAR; PG8_MMA(1, 0, At, B0); PG8_MMA(1, 1, At, B1); PG8_BAR; PG8_SCHED;
            PG8_LDB(B0, 1, 0); PG8_LDB(B1, 1, 1); PG8_SCHED; PG8_LDA(At, 1, 0); PG8_STAGE(PG8_SA(0, 1), a2 + hstep, voffA);
            PG8_WAIT_V(8); PG8_WAIT_L(0); PG8_BAR; PG8_MMA(0, 0, At, B0); PG8_MMA(0, 1, At, B1); PG8_BAR; PG8_SCHED;
            PG8_LDA(At, 1, 1); PG8_STAGE(PG8_SB(1, 0), b3, voffB); PG8_STAGE(PG8_SB(1, 1), b3 + hstep, voffB); PG8_STAGE(PG8_SA(1, 0), a3, voffA);
            PG8_WAIT_V(8); PG8_WAIT_L(0); PG8_BAR; PG8_MMA(1, 0, At, B0); PG8_MMA(1, 1, At, B1); PG8_BAR; PG8_SCHED;
            } else {
            PG8_LDB(B0, 0, 0); PG8_SCHED; PG8_LDA(At, 0, 0); PG8_STAGE(PG8_SA(1, 1), a1 + hstep, voffA);
            PG8_WAIT_L(8); PG8_BAR; PG8_WAIT_L(0); PG8_MMA(0, 0, At, B0); PG8_BAR; PG8_SCHED;
            PG8_LDB(B1, 0, 1); PG8_STAGE(PG8_SB(0, 0), b2, voffB);
            PG8_BAR; PG8_WAIT_L(0); PG8_MMA(0, 1, At, B1); PG8_BAR;
            PG8_LDA(At, 0, 1); PG8_STAGE(PG8_SA(0, 0), a2, voffA);
            PG8_BAR; PG8_WAIT_L(0); PG8_MMA(1, 0, At, B0); PG8_BAR; PG8_SCHED;
            PG8_STAGE(PG8_SB(0, 1), b2 + hstep, voffB);
            PG8_WAIT_V(6); PG8_BAR; PG8_MMA(1, 1, At, B1); PG8_BAR;
            PG8_LDB(B0, 1, 0); PG8_SCHED; PG8_LDA(At, 1, 0); PG8_STAGE(PG8_SA(0, 1), a2 + hstep, voffA);
            PG8_WAIT_L(8); PG8_BAR; PG8_WAIT_L(0); PG8_MMA(0, 0, At, B0); PG8_BAR; PG8_SCHED;
            PG8_LDB(B1, 1, 1); PG8_STAGE(PG8_SB(1, 0), b3, voffB);
            PG8_BAR; PG8_WAIT_L(0); PG8_MMA(0, 1, At, B1); PG8_BAR;
            PG8_LDA(At, 1, 1); PG8_STAGE(PG8_SA(1, 0), a3, voffA);
            PG8_BAR; PG8_WAIT_L(0); PG8_MMA(1, 0, At, B0); PG8_BAR; PG8_SCHED;
            PG8_STAGE(PG8_SB(1, 1), b3 + hstep, voffB);
            PG8_WAIT_V(6); PG8_BAR; PG8_MMA(1, 1, At, B1); PG8_BAR;
            }
        }
        if constexpr (ALIGN_EPI) { if (wr == 0) PG8_BAR; }
        if constexpr (!Epi::AFTER_DRAIN) { DIL_BEGIN(50); E(acc, cur, wr, wc, fr, fq); DIL_END(50); S.done(cur); }
        if (!has_next) break;
#pragma unroll
        for (int a = 0; a < 2; ++a)
#pragma unroll
            for (int b = 0; b < 2; ++b)
#pragma unroll
                for (int m = 0; m < 4; ++m)
#pragma unroll
                    for (int n = 0; n < 2; ++n) acc[a][b][m][n] = (f32x4){0.f, 0.f, 0.f, 0.f};
        cur = nxt; cA = nA; cB = nB; ++ui;
        if constexpr (ALIGN_EPI) { if (wr == 1) PG8_BAR; }
    }
    PG8_WAIT_V(0);
    if constexpr (!ALIGN_EPI) { if (wr == 0) PG8_BAR; }
    PG8_BAR;
    if constexpr (Epi::AFTER_DRAIN) { E.fused(acc, cur, wr, wc, fr, fq, lds, wid, lane); S.done(cur); }
#undef PG8_SA
#undef PG8_SB
#undef PG8_STAGE
#undef PG8_LDA
#undef PG8_LDB
#undef PG8_MMA
#undef PG8_WAIT_V
#undef PG8_WAIT_L
#undef PG8_BAR
#undef PG8_SCHED
}
}


#define LAS __attribute__((address_space(3)))
#define GAS __attribute__((address_space(1)))
typedef _Float16 h16;
typedef _Float16 h16x8 __attribute__((ext_vector_type(8)));
typedef _Float16 h16x4 __attribute__((ext_vector_type(4)));
typedef _Float16 h16x2 __attribute__((ext_vector_type(2)));
typedef float f32x2 __attribute__((ext_vector_type(2)));
typedef float f32x4 __attribute__((ext_vector_type(4)));
typedef float f32x16 __attribute__((ext_vector_type(16)));
typedef unsigned u32x4 __attribute__((ext_vector_type(4)));
typedef unsigned u32x2 __attribute__((ext_vector_type(2)));
typedef short s16x4 __attribute__((ext_vector_type(4)));

constexpr int NWAVES = 8;
constexpr int DM = 1024, NBATCH = 8, SEQ = 4096, T = NBATCH * SEQ, INW = 5544;
constexpr int NPHYS = 5632;
constexpr int NMAIN = 5120;
constexpr float EPS = 1e-6f;
constexpr float LOG2E = 1.4426950408889634f;
constexpr float QSCALE = 0.125f * LOG2E;
#ifndef MK_N_LAUNCHES
#define MK_N_LAUNCHES 1
#endif
constexpr int N_LAUNCHES = MK_N_LAUNCHES;
constexpr int PER_PHASE = 6;

constexpr size_t MiB = 1u << 20;
constexpr size_t WS_CTL = 0, CTL_ZERO_BYTES = 1 * MiB;
constexpr size_t WS_WIN = 2 * MiB, WS_WA = 13 * MiB, WS_WB = 14 * MiB, WS_WOUT = 15 * MiB;
constexpr size_t WS_ROPEB = 17 * MiB, WS_ROPEI = WS_ROPEB + 256 * 1024, WS_BIAS = WS_ROPEI + 128 * 1024;
constexpr size_t WS_IW = 18 * MiB, WS_IK = 19 * MiB, WS_KVB = 21 * MiB, WS_IQ = 29 * MiB;
constexpr size_t WS_XN = 48 * MiB;
constexpr size_t WS_QA = 112 * MiB, WS_KA = 144 * MiB, WS_VAT = 176 * MiB, WS_GA = 210 * MiB, WS_QB = 242 * MiB, WS_GB = 274 * MiB;
constexpr size_t WS_GTA = 306 * MiB, WS_GTB = 370 * MiB, WS_END = 434 * MiB;
constexpr size_t WS_YA = WS_XN, WS_YB = WS_XN + 32 * MiB, WS_TMP = WS_QA, WS_MERGED = WS_GA, WS_Y3 = WS_GTA;
constexpr int CW_BAR = 4096;

constexpr int RING_BYTES = 131072;
constexpr int LDS_HIST = 131072, LDS_IDX = LDS_HIST + 8 * 2048, LDSCTL_OFF = LDS_IDX + 8 * 512, MISC_OFF = LDSCTL_OFF + 320, LDS_MM = LDSCTL_OFF + 512, LDS_TC = LDSCTL_OFF + 640;
constexpr int LDS_BYTES = LDSCTL_OFF + 1024;

__device__ __forceinline__ unsigned pkh(float lo, float hi) { f32x2 v = {lo, hi}; h16x2 h = __builtin_convertvector(v, h16x2); return __builtin_bit_cast(unsigned, h); }
__device__ __forceinline__ float fexp2(float x) { return __builtin_amdgcn_exp2f(x); }
__device__ __forceinline__ float frcp(float x) { return __builtin_amdgcn_rcpf(x); }
__device__ __forceinline__ float sigmoidf_(float v) { return frcp(1.0f + fexp2(-v * LOG2E)); }
__device__ __forceinline__ float siluf_(float v) { return v * sigmoidf_(v); }
__device__ __forceinline__ float wave_sum(float v) {
#pragma unroll
    for (int o = 1; o < 64; o <<= 1) v += __shfl_xor(v, o);
    return v;
}
__device__ __forceinline__ float wave_max(float v) {
#pragma unroll
    for (int o = 1; o < 64; o <<= 1) v = fmaxf(v, __shfl_xor(v, o));
    return v;
}
__device__ __forceinline__ float wave_min(float v) {
#pragma unroll
    for (int o = 1; o < 64; o <<= 1) v = fminf(v, __shfl_xor(v, o));
    return v;
}
__device__ __forceinline__ unsigned wave_sum_u(unsigned v) {
#pragma unroll
    for (int o = 1; o < 64; o <<= 1) v += __shfl_xor(v, o);
    return v;
}

namespace epi {
using pg8::Unit;
__device__ __forceinline__ void store8(h16* p, const f32x4& a, const f32x4& b) {
    u32x4 w; w.x = pkh(a[0], a[1]); w.y = pkh(a[2], a[3]); w.z = pkh(b[0], b[1]); w.w = pkh(b[2], b[3]); *(u32x4*)p = w;
}
__device__ __forceinline__ u32x4 xch_rows(LAS unsigned char* xb, const u32x4 v, int lane) {
    *(LAS u32x4*)(xb + (lane & 15) * 80 + (lane >> 4) * 16) = v;
    return *(const LAS u32x4*)(xb + (lane >> 2) * 80 + (lane & 3) * 16);
}
__device__ __forceinline__ u32x4 xch_frag(LAS unsigned char* xb, const u32x4 v, int lane) {
    *(LAS u32x4*)(xb + (lane >> 2) * 80 + (lane & 3) * 16) = v;
    return *(const LAS u32x4*)(xb + (lane & 15) * 80 + (lane >> 4) * 16);
}
__device__ __forceinline__ void st_nt(void* p, const u32x4 v) { __builtin_nontemporal_store(v, (u32x4*)p); }
__device__ __forceinline__ u32x4 ld_nt(const void* p) { return __builtin_nontemporal_load((const u32x4*)p); }
__device__ __forceinline__ u32x4 pack8(const f32x4& a, const f32x4& b) { u32x4 w; w.x = pkh(a[0], a[1]); w.y = pkh(a[2], a[3]); w.z = pkh(b[0], b[1]); w.w = pkh(b[2], b[3]); return w; }
__device__ __forceinline__ void rope4(f32x4& v0, f32x4& v1, const float* tab) {
    const f32x4 t0 = *(const f32x4*)tab, t1 = *(const f32x4*)(tab + 4);
    float a, b;
    a = v0[0]; b = v0[1]; v0[0] = a * t0[0] - b * t0[1]; v0[1] = b * t0[0] + a * t0[1];
    a = v0[2]; b = v0[3]; v0[2] = a * t0[2] - b * t0[3]; v0[3] = b * t0[2] + a * t0[3];
    a = v1[0]; b = v1[1]; v1[0] = a * t1[0] - b * t1[1]; v1[1] = b * t1[0] + a * t1[1];
    a = v1[2]; b = v1[3]; v1[2] = a * t1[2] - b * t1[3]; v1[3] = b * t1[2] + a * t1[3];
}
struct EpiProj {
    static constexpr bool PERM = true, AFTER_DRAIN = false;
    h16 *QA, *KA, *GA, *QB, *GB, *GTA, *GTB, *KVB, *IQ, *IK; float* IW; const float* bm; const float* ropeb; const float* ropei; LAS unsigned char* xb;
    __device__ __forceinline__ void operator()(const f32x4 (&acc)[2][2][4][2], const Unit& u, int wr, int wc, int fr, int fq) const {
        const int pn = u.pn, row0 = u.pm * 256 + wr * 64 + fr;
        const int lane = fq * 16 + fr, rowx0 = u.pm * 256 + wr * 64 + (lane >> 2), clx = wc * 32 + 8 * (lane & 3);
        if (pn < 18) {
            h16* base; int ldc, colt, kind; const float* bias = nullptr;
            if (pn < 2) { base = QA; ldc = 512; colt = 256 * pn; kind = 1; }
            else if (pn < 4) { base = KA; ldc = 512; colt = 256 * (pn - 2); kind = 0; }
            else if (pn < 6) { base = GA; ldc = 512; colt = 256 * (pn - 4); kind = 2; }
            else if (pn < 8) { base = QB; ldc = 512; colt = 256 * (pn - 6); kind = 4; }
            else if (pn < 10) { base = GB; ldc = 512; colt = 256 * (pn - 8); kind = 2; }
            else if (pn < 14) { base = GTA; ldc = 1024; colt = 256 * (pn - 10); kind = 3; bias = bm + colt; }
            else { base = GTB; ldc = 1024; colt = 256 * (pn - 14); kind = 3; bias = bm + 1024 + colt; }
            const int cl = wc * 32 + 8 * fq;
            f32x4 bv[2][2];
#pragma unroll
            for (int bj = 0; bj < 2; ++bj)
#pragma unroll
                for (int n = 0; n < 2; ++n) bv[bj][n] = (kind == 3) ? *(const f32x4*)(bias + bj * 128 + cl + 4 * n) : (f32x4){0.f, 0.f, 0.f, 0.f};
            const bool ropel = (kind == 4) && ((wc & 1) == 0) && (fq < 2);
#pragma unroll
            for (int ai = 0; ai < 2; ++ai)
#pragma unroll
                for (int m = 0; m < 4; ++m) {
                    const int row = row0 + ai * 128 + m * 16;
                    h16* rowp = base + (size_t)(rowx0 + ai * 128 + m * 16) * ldc + colt + clx;
                    const int kpos = row & (SEQ - 1), kslot = (kpos & 19) | ((kpos & 4) << 1) | ((kpos & 8) >> 1);
                    const size_t kbase = ((size_t)(row >> 12) * 8) * 128 + (size_t)(kpos >> 5);
#pragma unroll
                    for (int bj = 0; bj < 2; ++bj) {
                        f32x4 v0 = acc[ai][bj][m][0], v1 = acc[ai][bj][m][1];
                        if (kind == 1) { v0 = v0 * QSCALE; v1 = v1 * QSCALE; }
                        else if (kind == 2) {
#pragma unroll
                            for (int e = 0; e < 4; ++e) { v0[e] = siluf_(v0[e]); v1[e] = siluf_(v1[e]); }
                        } else if (kind == 3) {
                            v0 = v0 + bv[bj][0]; v1 = v1 + bv[bj][1];
#pragma unroll
                            for (int e = 0; e < 4; ++e) { v0[e] = sigmoidf_(v0[e]); v1[e] = sigmoidf_(v1[e]); }
                        } else if (kind == 4) {
                            if (ropel) rope4(v0, v1, ropeb + (size_t)(row & (SEQ - 1)) * 16 + fq * 8);
                            v0 = v0 * QSCALE; v1 = v1 * QSCALE;
                        }
                        if (pn == 2 || pn == 3) {
                            const int cc = colt + bj * 128 + cl, hd = cc >> 6, dc = (cc & 63) >> 3;
                            st_nt(KA + (((kbase + (size_t)hd * 128) * 8 + dc) * 32 + kslot) * 8, pack8(v0, v1));
                        } else st_nt(rowp + bj * 128, xch_rows(xb + ((m * 2 + bj) & 1) * 1280, pack8(v0, v1), lane));
                    }
                }
        } else {
#pragma unroll
            for (int bj = 0; bj < 2; ++bj) {
                const int G = (pn - 18) * 8 + bj * 4 + wc;
                if (G >= 14) continue;
#pragma unroll
                for (int ai = 0; ai < 2; ++ai)
#pragma unroll
                    for (int m = 0; m < 4; ++m) {
                        const int row = row0 + ai * 128 + m * 16, pos = row & (SEQ - 1);
                        f32x4 v0 = acc[ai][bj][m][0], v1 = acc[ai][bj][m][1];
                        if (G < 4) {
                            if (G == 0 && fq < 2) rope4(v0, v1, ropeb + (size_t)pos * 16 + fq * 8);
                            *(u32x4*)(KVB + (size_t)(rowx0 + ai * 128 + m * 16) * 128 + G * 32 + 8 * (lane & 3)) = xch_rows(xb + (m & 1) * 1280, pack8(v0, v1), lane);
                        } else if (G < 12) {
                            if (fq == 0) rope4(v0, v1, ropei + (size_t)pos * 8);
                            *(u32x4*)(IQ + (size_t)(rowx0 + ai * 128 + m * 16) * 256 + (G - 4) * 32 + 8 * (lane & 3)) = xch_rows(xb + (m & 1) * 1280, pack8(v0, v1), lane);
                        } else if (G == 12) {
                            if (fq == 0) rope4(v0, v1, ropei + (size_t)pos * 8);
                            store8(IK + ((((size_t)(row >> 4)) * 4 + fq) * 16 + (row & 15)) * 8, v0, v1);
                        } else {
                            if (fq == 0) { *(f32x4*)(IW + (size_t)row * 8) = v0 * 0.0625f; *(f32x4*)(IW + (size_t)row * 8 + 4) = v1 * 0.0625f; }
                        }
                    }
            }
        }
    }
};
struct EpiVT {
    static constexpr bool PERM = true, AFTER_DRAIN = false;
    h16* VT;
    __device__ __forceinline__ void operator()(const f32x4 (&acc)[2][2][4][2], const Unit& u, int wr, int wc, int fr, int fq) const {
        const int row0 = u.pm * 256 + wr * 64 + fr, col0 = u.pn * 256 + wc * 32 + 8 * fq;
#pragma unroll
        for (int ai = 0; ai < 2; ++ai)
#pragma unroll
            for (int m = 0; m < 4; ++m) { const int R = row0 + ai * 128 + m * 16, hd = R >> 6, dd = R & 63;
#pragma unroll
                for (int bj = 0; bj < 2; ++bj) { const int tok = col0 + bj * 128, bb = tok >> 12, kg = (tok & (SEQ - 1)) >> 3;
                    st_nt(VT + ((((size_t)bb * 8 + hd) * 512 + kg) * 64 + dd) * 8, pack8(acc[ai][bj][m][0], acc[ai][bj][m][1])); } }
    }
};
struct EpiPlain {
    static constexpr bool PERM = true, AFTER_DRAIN = false;
    h16* C; int ldc; LAS unsigned char* xb;
    __device__ __forceinline__ void operator()(const f32x4 (&acc)[2][2][4][2], const Unit& u, int wr, int wc, int fr, int fq) const {
        const int lane = fq * 16 + fr, row0 = u.pm * 256 + wr * 64 + (lane >> 2), col0 = u.pn * 256 + wc * 32 + 8 * (lane & 3);
#pragma unroll
        for (int ai = 0; ai < 2; ++ai)
#pragma unroll
            for (int m = 0; m < 4; ++m) { h16* rowp = C + (size_t)(row0 + ai * 128 + m * 16) * ldc + col0;
#pragma unroll
                for (int bj = 0; bj < 2; ++bj) *(u32x4*)(rowp + bj * 128) = xch_rows(xb + ((m * 2 + bj) & 1) * 1280, pack8(acc[ai][bj][m][0], acc[ai][bj][m][1]), lane); }
    }
};
template <int MODE> struct EpiGate {
    static constexpr bool PERM = true, AFTER_DRAIN = false;
    const h16* G1; const h16* G2; h16* OUT; LAS unsigned char* xb;
    __device__ __forceinline__ void operator()(const f32x4 (&acc)[2][2][4][2], const Unit& u, int wr, int wc, int fr, int fq) const {
        const int lane = fq * 16 + fr, row0 = u.pm * 256 + wr * 64 + (lane >> 2), col0 = u.pn * 256 + wc * 32 + 8 * (lane & 3);
#pragma unroll
        for (int ai = 0; ai < 2; ++ai)
#pragma unroll
            for (int m = 0; m < 4; ++m) { const size_t off = (size_t)(row0 + ai * 128 + m * 16) * 1024 + col0;
#pragma unroll
                for (int bj = 0; bj < 2; ++bj) {
                    LAS unsigned char* xw = xb + ((m * 2 + bj) & 1) * 1280;
                    const h16x8 g1 = __builtin_bit_cast(h16x8, xch_frag(xw, MODE == 0 ? ld_nt(G1 + off + bj * 128) : *(const u32x4*)(G1 + off + bj * 128), lane));
                    f32x4 v0 = acc[ai][bj][m][0], v1 = acc[ai][bj][m][1];
                    if (MODE == 0) {
#pragma unroll
                        for (int e = 0; e < 4; ++e) { v0[e] *= (float)g1[e]; v1[e] *= (float)g1[4 + e]; }
                    } else {
                        const h16x8 g2 = __builtin_bit_cast(h16x8, xch_frag(xw, ld_nt(G2 + off + bj * 128), lane));
#pragma unroll
                        for (int e = 0; e < 4; ++e) { v0[e] = (float)g1[e] + (float)g2[e] * v0[e]; v1[e] = (float)g1[4 + e] + (float)g2[4 + e] * v1[e]; }
                    }
                    *(u32x4*)(OUT + off + bj * 128) = xch_rows(xw, pack8(v0, v1), lane);
                } }
    }
};
}

typedef GAS unsigned gu32;
#define XB_TMO      128
#define XB_XCNT(j)  (256  + 64 * (j))
#define XB_XSUB(j)  (1280 + 64 * (j))
#define XB_XGEN(j)  (2304 + 64 * (j))
#define XB_TOP      3328
#define XB_TOPGEN   3392
#define XCD_BAR_WORDS 3456
#define XB_SPIN_CAP (1u << 18)
__device__ __forceinline__ unsigned xb_ld(unsigned* p)              { return __hip_atomic_load(p, __ATOMIC_RELAXED, __HIP_MEMORY_SCOPE_AGENT); }
__device__ __forceinline__ unsigned xb_add(unsigned* p, unsigned v) { return __hip_atomic_fetch_add(p, v, __ATOMIC_RELAXED, __HIP_MEMORY_SCOPE_AGENT); }
__device__ __forceinline__ unsigned xb_xcc_id() { return (unsigned)__builtin_amdgcn_s_getreg((3 << 11) | 20) & 0xFu; }
#define XB_SPIN(cond, bar) do { unsigned _sp = 0; while (cond) { __builtin_amdgcn_s_sleep(1); \
    if ((++_sp & 255u) == 0u) { if (xb_ld(&(bar)[XB_TMO])) break; if (_sp > XB_SPIN_CAP) { atomicAdd(&(bar)[XB_TMO], 1u); break; } } } } while (0)
struct XcdBarrier { unsigned* bar; unsigned x; volatile LAS unsigned* st; };
__device__ __forceinline__ XcdBarrier xcd_barrier_post(unsigned* bar, volatile LAS unsigned* st) {
    XcdBarrier b; b.bar = bar; b.x = xb_xcc_id(); b.st = st;
    if (threadIdx.x == 0) (void)xb_add(&bar[XB_XCNT(b.x)], 1u);
    return b;
}
__device__ __forceinline__ void xcd_barrier_complete(unsigned* bar, unsigned x, unsigned& nloc, unsigned& nx) {
    const unsigned G = gridDim.x * gridDim.y * gridDim.z;
    unsigned sum, cnt, mine, sp = 0u;
    for (;;) {
        sum = 0u; cnt = 0u; mine = 0u;
#pragma unroll
        for (unsigned j = 0; j < 16; ++j) { const unsigned c = xb_ld(&bar[XB_XCNT(j)]); sum += c; cnt += (c > 0u) ? 1u : 0u; mine = (j == x) ? c : mine; }
        if (sum == G) break;
        __builtin_amdgcn_s_sleep(1);
        if ((++sp & 255u) == 0u) { if (xb_ld(&bar[XB_TMO])) break; if (sp > XB_SPIN_CAP) { atomicAdd(&bar[XB_TMO], 1u); break; } }
    }
    nloc = mine > 0u ? mine : 1u; nx = cnt > 0u ? cnt : 1u;
}
__device__ __forceinline__ void xcd_barrier(const XcdBarrier& b) {
    asm volatile("s_waitcnt vmcnt(0)" ::: "memory");
    __syncthreads();
    if (threadIdx.x == 0) {
        unsigned* bar = b.bar;
        __builtin_amdgcn_s_waitcnt(0);
        unsigned nloc = b.st[0], nx = b.st[1];
        if (nloc == 0u) { xcd_barrier_complete(bar, b.x, nloc, nx); b.st[0] = nloc; b.st[1] = nx; }
        const unsigned old = xb_add(&bar[XB_XSUB(b.x)], 1u);
        const unsigned gen = old / nloc;
        if (old + 1u == (gen + 1u) * nloc) {
            __builtin_amdgcn_fence(__ATOMIC_RELEASE, "agent");
            asm volatile("s_waitcnt vmcnt(0)" ::: "memory");
            const unsigned og = xb_add(&bar[XB_TOP], 1u);
            const unsigned tg = og / nx;
            if (og + 1u == (tg + 1u) * nx) xb_add(&bar[XB_TOPGEN], 1u);
            else XB_SPIN(xb_ld(&bar[XB_TOPGEN]) == tg, bar);
            __builtin_amdgcn_fence(__ATOMIC_ACQUIRE, "agent");
            xb_add(&bar[XB_XGEN(b.x)], 1u);
            asm volatile("s_waitcnt vmcnt(0)" ::: "memory");
        } else {
            XB_SPIN(xb_ld(&bar[XB_XGEN(b.x)]) == gen, bar);
            __builtin_amdgcn_fence(__ATOMIC_ACQUIRE, "agent");
            asm volatile("s_waitcnt vmcnt(0)" ::: "memory");
        }
    }
    __syncthreads();
}

struct Frame {
    LAS unsigned char* lds; int tid, lane, wave, vcu, G;
    const float *x, *g1, *w_in, *bm, *relb, *wa, *wb, *wo, *g2; float* out;
    h16 *WIN, *WA, *WB, *WOUT, *XN, *QA, *KA, *VAT, *GA, *QB, *GB, *GTA, *GTB, *KVB, *IQ, *IK, *YA, *YB, *TMP, *MERGED, *Y3;
    float *IW, *ROPEB, *ROPEI, *BIAS;
};

__device__ __forceinline__ int win_src_col(int j) {
    if (j < 1024) return j;
    if (j < 1536) return 1536 + (j - 1024);
    if (j < 2048) { const int o = j - 1536, hd = o >> 6, p = o & 63; const int lp = p < 16 ? ((p & 1) * 8 + (p >> 1)) : p; return 2048 + hd * 64 + lp; }
    if (j < 2560) return 2688 + (j - 2048);
    if (j < 3584) return 3496 + (j - 2560);
    if (j < 4608) return 4520 + (j - 3584);
    if (j < 5120) { const int o = j - 4608;
        if (o < 64) { const int lp = o < 16 ? ((o & 1) * 8 + (o >> 1)) : o; return 2560 + lp; }
        if (o < 128) return 2624 + (o - 64);
        if (o < 384) { const int q = o - 128, hd = q >> 5, p = q & 31; const int lp = p < 8 ? ((p & 1) * 4 + (p >> 1)) : p; return 3200 + hd * 32 + lp; }
        if (o < 416) { const int p = o - 384; const int lp = p < 8 ? ((p & 1) * 4 + (p >> 1)) : p; return 3456 + lp; }
        if (o < 424) return 3488 + (o - 416);
        return -1; }
    return 1024 + (j - 5120);
}
template <bool MAP> __device__ __forceinline__ void p0_transpose_item(const float* W, int K, int N, h16* WT, LAS float* scr, int item, int lane) {
    const int kblk = K / 64, nb = item / kblk, kb = item % kblk, k0 = 64 * kb, j0 = 32 * nb;
    const int src = MAP ? win_src_col(j0 + (lane & 31)) : (j0 + (lane & 31));
#pragma unroll 8
    for (int i = 0; i < 32; ++i) { const int kk = 2 * i + (lane >> 5); scr[kk * 33 + (lane & 31)] = (src >= 0) ? __builtin_nontemporal_load(W + (size_t)(k0 + kk) * N + src) : 0.f; }
    asm volatile("s_waitcnt lgkmcnt(0)" ::: "memory");
    const int c = lane & 7;
#pragma unroll
    for (int j = 0; j < 4; ++j) { const int n = (lane >> 3) + 8 * j; const LAS float* s = scr + (8 * c) * 33 + n;
        u32x4 o; o.x = pkh(s[0 * 33], s[1 * 33]); o.y = pkh(s[2 * 33], s[3 * 33]); o.z = pkh(s[4 * 33], s[5 * 33]); o.w = pkh(s[6 * 33], s[7 * 33]);
        *(u32x4*)(WT + (size_t)(j0 + n) * K + k0 + 8 * c) = o; }
    asm volatile("s_waitcnt lgkmcnt(0)" ::: "memory");
}
__device__ __forceinline__ void sincos_acc(float angf, float& c, float& s) {
    const double a = (double)angf;
    const double k = rint(a * 0.63661977236758134308);
    const double r = (a - k * 1.5707963267948966192) - k * 6.123233995736766e-17;
    const double r2 = r * r;
    const double sp = r * (1.0 + r2 * (-1.0 / 6 + r2 * (1.0 / 120 + r2 * (-1.0 / 5040 + r2 * (1.0 / 362880 + r2 * (-1.0 / 39916800 + r2 * (1.0 / 6227020800.0 + r2 * (-1.0 / 1307674368000.0))))))));
    const double cp = 1.0 + r2 * (-0.5 + r2 * (1.0 / 24 + r2 * (-1.0 / 720 + r2 * (1.0 / 40320 + r2 * (-1.0 / 3628800 + r2 * (1.0 / 479001600.0 + r2 * (-1.0 / 87178291200.0 + r2 * (1.0 / 20922789888000.0))))))));
    const int q = ((int)(long long)k) & 3;
    const double sv = (q == 0) ? sp : (q == 1) ? cp : (q == 2) ? -sp : -cp;
    const double cv = (q == 0) ? cp : (q == 1) ? -sp : (q == 2) ? -cp : sp;
    c = (float)cv; s = (float)sv;
}
__device__ __forceinline__ void p0_prologue(Frame& F) {
    LAS float* scr = (LAS float*)(F.lds + F.wave * 16384);
    const int gw = F.vcu * NWAVES + F.wave, NGW = F.G * NWAVES;
    constexpr int I_IN = (NPHYS / 32) * (DM / 64), I_A = (DM / 32) * (512 / 64), I_O = (DM / 32) * (DM / 64);
    constexpr int NITEMS = I_IN + 2 * I_A + I_O;
    DIL_BEGIN(60);
    for (int it = gw; it < NITEMS; it += NGW) {
        int r = it;
        if (r < I_IN) { p0_transpose_item<true>(F.w_in, DM, INW, F.WIN, scr, r, F.lane); continue; } r -= I_IN;
        if (r < I_A) { p0_transpose_item<false>(F.wa, 512, DM, F.WA, scr, r, F.lane); continue; } r -= I_A;
        if (r < I_A) { p0_transpose_item<false>(F.wb, 512, DM, F.WB, scr, r, F.lane); continue; } r -= I_A;
        p0_transpose_item<false>(F.wo, DM, DM, F.WOUT, scr, r, F.lane);
    }
    DIL_END(60);
    DIL_BEGIN(61);
    {
        f32x4 gv[4];
#pragma unroll
        for (int j = 0; j < 4; ++j) gv[j] = ((const f32x4*)F.g1)[F.lane + 64 * j];
        for (int m = gw; m < T; m += 2 * NGW) {
            const f32x4* xr0 = (const f32x4*)(F.x + (size_t)m * DM) + F.lane; const f32x4* xr1 = (const f32x4*)(F.x + (size_t)(m + NGW) * DM) + F.lane;
            f32x4 v0[4], v1[4]; float s0 = 0.f, s1 = 0.f;
#pragma unroll
            for (int j = 0; j < 4; ++j) { v0[j] = __builtin_nontemporal_load(xr0 + 64 * j); v1[j] = __builtin_nontemporal_load(xr1 + 64 * j); }
#pragma unroll
            for (int j = 0; j < 4; ++j) { s0 += (v0[j].x * v0[j].x + v0[j].y * v0[j].y) + (v0[j].z * v0[j].z + v0[j].w * v0[j].w); s1 += (v1[j].x * v1[j].x + v1[j].y * v1[j].y) + (v1[j].z * v1[j].z + v1[j].w * v1[j].w); }
            const float rs0 = 1.0f / sqrtf(wave_sum(s0) * (1.0f / DM) + EPS), rs1 = 1.0f / sqrtf(wave_sum(s1) * (1.0f / DM) + EPS);
            u32x2* o0 = (u32x2*)(F.XN + (size_t)m * DM) + F.lane; u32x2* o1 = (u32x2*)(F.XN + (size_t)(m + NGW) * DM) + F.lane;
#pragma unroll
            for (int j = 0; j < 4; ++j) { const f32x4 y0 = v0[j] * rs0 * gv[j], y1 = v1[j] * rs1 * gv[j]; u32x2 w0, w1; w0.x = pkh(y0.x, y0.y); w0.y = pkh(y0.z, y0.w); w1.x = pkh(y1.x, y1.y); w1.y = pkh(y1.z, y1.w); o0[64 * j] = w0; o1[64 * j] = w1; }
        }
    }
    DIL_END(61);
    DIL_BEGIN(62);
    const int gt = F.vcu * (NWAVES * 64) + F.tid, NGT = F.G * NWAVES * 64;
    for (int idx = gt; idx < SEQ * 12; idx += NGT) {
        const int pos = idx / 12, e = idx % 12; const int half = e < 8 ? 8 : 4, i = e < 8 ? e : e - 8;
        const float inv = powf(500000.0f, -(float)i / (float)half);
        const float ang = (float)pos * inv; float c, s; sincos_acc(ang, c, s);
        float* dst = e < 8 ? (F.ROPEB + (size_t)pos * 16 + 2 * i) : (F.ROPEI + (size_t)pos * 8 + 2 * i);
        dst[0] = c; dst[1] = s;
    }
    for (int idx = gt; idx < 8 * 513; idx += NGT) F.BIAS[idx] = F.relb[idx] * LOG2E;
    DIL_END(62);
}

__device__ __forceinline__ float half_swap_max(float v) { auto rr = __builtin_amdgcn_permlane32_swap(__float_as_uint(v), __float_as_uint(v), false, false); return fmaxf(__uint_as_float(rr[0]), __uint_as_float(rr[1])); }
__device__ __forceinline__ float half_swap_sum(float v) { auto rr = __builtin_amdgcn_permlane32_swap(__float_as_uint(v), __float_as_uint(v), false, false); return __uint_as_float(rr[0]) + __uint_as_float(rr[1]); }
__device__ __forceinline__ void attn_a_unit(const Frame& F, int b, int h, int c, const LAS float* biasL) {
    const int lane = F.lane, r = lane & 31, hh = lane >> 5;
    const size_t tokbase = (size_t)b * SEQ; const int t0 = c * 64;
    h16x8 qf[2][4];
#pragma unroll
    for (int qb = 0; qb < 2; ++qb)
#pragma unroll
        for (int s = 0; s < 4; ++s) qf[qb][s] = *(const h16x8*)(F.QA + (tokbase + t0 + 32 * qb + r) * 512 + h * 64 + 16 * s + 8 * hh);
    f32x16 o[2][2];
#pragma unroll
    for (int a = 0; a < 2; ++a)
#pragma unroll
        for (int q = 0; q < 2; ++q)
#pragma unroll
            for (int e = 0; e < 16; ++e) o[a][q][e] = 0.f;
    float mrun[2] = {0.f, 0.f}, lrun[2] = {0.f, 0.f};
    const h16* Kb = F.KA + ((size_t)(b * 8 + h) * 128 * 8 * 32 + lane) * 8;
    const h16* Vb = F.VAT + (((size_t)(b * 8 + h) * 512 + hh) * 64 + r) * 8;
    const LAS float* bh = biasL + h * 448;
    const float bfar = bh[0];
    const int kc0 = c > 8 ? c - 8 : 0;
    const int nit = 2 * (c - kc0 + 1), sbase = kc0 * 64;
    h16x8 kf[4], vf[2][2], kn[4], vn[2][2];
#pragma unroll
    for (int s = 0; s < 4; ++s) kf[s] = *(const h16x8*)(Kb + (size_t)((sbase >> 5) * 4 + s) * 512);
#pragma unroll
    for (int dt = 0; dt < 2; ++dt)
#pragma unroll
        for (int sp = 0; sp < 2; ++sp) vf[dt][sp] = *(const h16x8*)(Vb + (size_t)(((sbase >> 3) + 2 * sp) * 64 + 32 * dt) * 8);
    {
#pragma unroll 1
        for (int it = 0; it < nit; ++it) {
            const int s0 = sbase + 32 * it;
            const int s1 = sbase + 32 * (it + 1 < nit ? it + 1 : it);
#pragma unroll
            for (int s = 0; s < 4; ++s) kn[s] = *(const h16x8*)(Kb + (size_t)((s1 >> 5) * 4 + s) * 512);
#pragma unroll
            for (int dt = 0; dt < 2; ++dt)
#pragma unroll
                for (int sp = 0; sp < 2; ++sp) vn[dt][sp] = *(const h16x8*)(Vb + (size_t)(((s1 >> 3) + 2 * sp) * 64 + 32 * dt) * 8);
            const int delta = t0 - s0;
#pragma unroll
            for (int qb = 0; qb < 2; ++qb) {
                f32x16 S;
                const float nm = -mrun[qb];
                if (delta + 32 * qb >= 288) {
                    const float c0 = bfar + nm;
#pragma unroll
                    for (int e = 0; e < 16; ++e) S[e] = c0;
                } else {
                    const LAS float* bp = bh + (320 - (delta + 32 * qb + r - 8 * hh));
#pragma unroll
                    for (int e = 0; e < 16; ++e) { const int kr = (e & 3) + 4 * ((e >> 2) & 1) + 16 * (e >> 3); S[e] = bp[kr] + nm; }
                }
#pragma unroll
                for (int s = 0; s < 4; ++s) S = __builtin_amdgcn_mfma_f32_32x32x16_f16(kf[s], qf[qb][s], S, 0, 0, 0);
                float tm = S[0];
#pragma unroll
                for (int e = 1; e < 16; ++e) tm = fmaxf(tm, S[e]);
                tm = half_swap_max(tm);
                if (it == 0 || __any(tm > 8.0f)) {
                    const float dl = it == 0 ? tm : fmaxf(tm, 0.f), alpha = fexp2(-dl);
                    mrun[qb] += dl; lrun[qb] *= alpha;
#pragma unroll
                    for (int e = 0; e < 16; ++e) S[e] -= dl;
#pragma unroll
                    for (int dt = 0; dt < 2; ++dt)
#pragma unroll
                        for (int e = 0; e < 16; ++e) o[dt][qb][e] *= alpha;
                }
                float ps = 0.f;
#pragma unroll
                for (int e = 0; e < 16; ++e) { S[e] = fexp2(S[e]); ps += S[e]; }
                lrun[qb] += ps;
                u32x4 pw[2];
#pragma unroll
                for (int sp = 0; sp < 2; ++sp) { pw[sp].x = pkh(S[8 * sp + 0], S[8 * sp + 1]); pw[sp].y = pkh(S[8 * sp + 2], S[8 * sp + 3]); pw[sp].z = pkh(S[8 * sp + 4], S[8 * sp + 5]); pw[sp].w = pkh(S[8 * sp + 6], S[8 * sp + 7]); }
#pragma unroll
                for (int dt = 0; dt < 2; ++dt)
#pragma unroll
                    for (int sp = 0; sp < 2; ++sp) o[dt][qb] = __builtin_amdgcn_mfma_f32_32x32x16_f16(vf[dt][sp], __builtin_bit_cast(h16x8, pw[sp]), o[dt][qb], 0, 0, 0);
            }
#pragma unroll
            for (int s = 0; s < 4; ++s) kf[s] = kn[s];
#pragma unroll
            for (int dt = 0; dt < 2; ++dt)
#pragma unroll
                for (int sp = 0; sp < 2; ++sp) vf[dt][sp] = vn[dt][sp];
        }
    }
#pragma unroll
    for (int qb = 0; qb < 2; ++qb) {
        const float inv = 1.0f / half_swap_sum(lrun[qb]);
        const size_t rowoff = (tokbase + t0 + 32 * qb + r) * 512 + h * 64;
#pragma unroll
        for (int dt = 0; dt < 2; ++dt)
#pragma unroll
            for (int g4 = 0; g4 < 4; ++g4) {
                const int d0 = 32 * dt + 8 * g4 + 4 * hh;
                const h16x4 ga = *(const h16x4*)(F.GA + rowoff + d0);
                u32x2 w; w.x = pkh(o[dt][qb][4 * g4 + 0] * inv * (float)ga[0], o[dt][qb][4 * g4 + 1] * inv * (float)ga[1]);
                w.y = pkh(o[dt][qb][4 * g4 + 2] * inv * (float)ga[2], o[dt][qb][4 * g4 + 3] * inv * (float)ga[3]);
                *(u32x2*)(F.YA + rowoff + d0) = w;
            }
    }
}

__device__ __forceinline__ unsigned fkey(float f) { const unsigned u = __float_as_uint(f); return (u & 0x80000000u) ? ~u : (u | 0x80000000u); }
__device__ __forceinline__ unsigned mbcnt64(unsigned long long m) { return __builtin_amdgcn_mbcnt_hi((unsigned)(m >> 32), __builtin_amdgcn_mbcnt_lo((unsigned)m, 0u)); }
#define SUBREP(k) ((REP_PHASE) == (k) ? 2 : 1)
__device__ __forceinline__ float unkey(unsigned k) { return __uint_as_float((k & 0x80000000u) ? (k & 0x7fffffffu) : ~k); }
__device__ __forceinline__ float dpp_ror8(float v) { return __uint_as_float((unsigned)__builtin_amdgcn_update_dpp((int)__float_as_uint(v), (int)__float_as_uint(v), 0x128, 0xf, 0xf, true)); }
__device__ __forceinline__ unsigned scan_incl_u(unsigned v) {
    v += (unsigned)__builtin_amdgcn_update_dpp(0, (int)v, 0x111, 0xf, 0xf, false);
    v += (unsigned)__builtin_amdgcn_update_dpp(0, (int)v, 0x112, 0xf, 0xf, false);
    v += (unsigned)__builtin_amdgcn_update_dpp(0, (int)v, 0x114, 0xf, 0xf, false);
    v += (unsigned)__builtin_amdgcn_update_dpp(0, (int)v, 0x118, 0xf, 0xf, false);
    v += (unsigned)__builtin_amdgcn_update_dpp(0, (int)v, 0x142, 0xa, 0xf, false);
    v += (unsigned)__builtin_amdgcn_update_dpp(0, (int)v, 0x143, 0xc, 0xf, false);
    return v;
}
__device__ __forceinline__ int exscan_u(unsigned v, int lane, unsigned& total) {
    const unsigned inc = scan_incl_u(v);
    total = (unsigned)__builtin_amdgcn_readlane((int)inc, 63);
    return (int)(inc - v);
}
__device__ __forceinline__ float x16_max(float v) { auto rr = __builtin_amdgcn_permlane16_swap(__float_as_uint(v), __float_as_uint(v), false, false); return fmaxf(__uint_as_float(rr[0]), __uint_as_float(rr[1])); }
__device__ __forceinline__ float x16_sum(float v) { auto rr = __builtin_amdgcn_permlane16_swap(__float_as_uint(v), __float_as_uint(v), false, false); return __uint_as_float(rr[0]) + __uint_as_float(rr[1]); }
__device__ __forceinline__ void dsa_unit(const Frame& F, int b, int qg, int par) {
    const int lane = F.lane, wave = F.wave;
    const size_t tokbase = (size_t)b * SEQ; const int t0 = qg * 8, c = t0 >> 6, n = (c + 1) * 64;
    LAS float* scores = (LAS float*)F.lds;
    LAS float* row = scores + wave * 4096;
    LAS unsigned* hist = (LAS unsigned*)(F.lds + LDS_HIST) + wave * 512;
    LAS unsigned short* idxl = (LAS unsigned short*)(F.lds + LDS_IDX) + wave * 256;
    LAS unsigned* mm = (LAS unsigned*)(F.lds + LDS_MM) + 16 * par;
    DIL_BEGIN(10);
    if (n > 256) {
        for (int rp = 0; rp < SUBREP(7); ++rp) {
            DIL_BEGIN(15);
            const int q = lane & 7, hs = (lane >> 3) & 1, g = lane >> 4;
            h16x8 bq[4]; float w[4];
#pragma unroll
            for (int hp = 0; hp < 4; ++hp) { bq[hp] = *(const h16x8*)(F.IQ + (tokbase + t0 + q) * 256 + (2 * hp + hs) * 32 + 8 * g); w[hp] = 0.5f * F.IW[(tokbase + t0 + q) * 8 + 2 * hp + hs]; }
            h16x8 blin;
            {
                float bl[8];
#pragma unroll
                for (int j = 0; j < 8; ++j) { bl[j] = 0.f;
#pragma unroll
                    for (int hp = 0; hp < 4; ++hp) bl[j] += w[hp] * (float)bq[hp][j]; }
#pragma unroll
                for (int j = 0; j < 8; ++j) { bl[j] += dpp_ror8(bl[j]); const h16 hi = (h16)bl[j]; const h16 lo = (h16)(bl[j] - (float)hi); blin[j] = hs == 0 ? hi : lo; }
            }
            DIL_END(15);
            DIL_BEGIN(16);
            LAS float* sp = scores + q * 4096 + 4 * (g ^ (q & 3)) + 16 * (wave + ((q >> 2) ? ((wave & 1) ? -1 : 1) : 0));
            const int ntile = n >> 4;
            const h16* ikp = F.IK + (tokbase / 16) * 512 + (size_t)lane * 8;
            float lmn = 3.0e38f, lmx = -3.0e38f;
            h16x8 ak[4], an[4];
            const int nmy = (ntile - wave + 7) >> 3;
#pragma unroll
            for (int u = 0; u < 4; ++u) { const int j = u < nmy ? u : nmy - 1; ak[u] = *(const h16x8*)(ikp + (size_t)(wave + 8 * j) * 512); }
            for (int j0 = 0; j0 < nmy; j0 += 4) {
#pragma unroll
                for (int u = 0; u < 4; ++u) { const int jj = j0 + 4 + u, j = jj < nmy ? jj : nmy - 1; an[u] = *(const h16x8*)(ikp + (size_t)(wave + 8 * j) * 512); }
#pragma unroll
                for (int u = 0; u < 4; ++u) {
                    const int tile = wave + 8 * (j0 + u);
                    if (j0 + u < nmy) {
                        f32x4 acc = {0.f, 0.f, 0.f, 0.f};
                        acc = __builtin_amdgcn_mfma_f32_16x16x32_f16(ak[u], blin, acc, 0, 0, 0);
#pragma unroll
                        for (int hp = 0; hp < 4; ++hp) {
                            f32x4 cz = {0.f, 0.f, 0.f, 0.f};
                            cz = __builtin_amdgcn_mfma_f32_16x16x32_f16(ak[u], bq[hp], cz, 0, 0, 0);
#pragma unroll
                            for (int e = 0; e < 4; ++e) { acc[e] = __builtin_fmaf(__builtin_fabsf(cz[e]), w[hp], acc[e]); asm volatile("" : "+v"(acc[e])); }
                        }
#pragma unroll
                        for (int e = 0; e < 4; ++e) { acc[e] += dpp_ror8(acc[e]); lmn = fminf(lmn, acc[e]); lmx = fmaxf(lmx, acc[e]); }
                        if (hs == 0) *(LAS f32x4*)(sp + 128 * (j0 + u)) = acc;
                    }
                }
#pragma unroll
                for (int u = 0; u < 4; ++u) ak[u] = an[u];
            }
            DIL_END(16);
            lmn = -half_swap_max(x16_max(-lmn)); lmx = half_swap_max(x16_max(lmx));
            if (lane < 8 && lmx >= lmn) { __hip_atomic_fetch_min(mm + lane, fkey(lmn), __ATOMIC_RELAXED, __HIP_MEMORY_SCOPE_WORKGROUP); __hip_atomic_fetch_max(mm + 8 + lane, fkey(lmx), __ATOMIC_RELAXED, __HIP_MEMORY_SCOPE_WORKGROUP); }
        }
    }
    DIL_END(10);
    DIL_BEGIN(13);
    __syncthreads();
    DIL_END(13);
    DIL_BEGIN(11);
    if (F.tid < 16) ((LAS unsigned*)(F.lds + LDS_MM))[16 * (par ^ 1) + F.tid] = F.tid < 8 ? 0xffffffffu : 0u;
    if (n > 256) for (int rp = 0; rp < SUBREP(8); ++rp) {
        DIL_BEGIN(20);
        const int ngrp = (n + 255) >> 8;
        const int nch = (4 * lane < n) ? ((n - 4 * lane + 255) >> 8) : 0;
        const unsigned long long validm = nch >= 16 ? ~0ull : ((1ull << (4 * nch)) - 1ull);
        f32x4 v4[16];
#pragma unroll
        for (int j = 0; j < 16; ++j) if (j < ngrp) v4[j] = *(const LAS f32x4*)(row + 4 * ((64 * j + lane) ^ wave));
        const float mn = unkey(mm[wave]), mx = unkey(mm[8 + wave]);
        const float range = mx - mn;
        const unsigned Rbits = ((__float_as_uint(range) >> 23) + 1u) << 23;
        const float cadd = __uint_as_float(Rbits) - mn;
        ((LAS u32x4*)hist)[lane * 2] = (u32x4){0u, 0u, 0u, 0u}; ((LAS u32x4*)hist)[lane * 2 + 1] = (u32x4){0u, 0u, 0u, 0u};
        asm volatile("s_waitcnt lgkmcnt(0)" ::: "memory");
        DIL_END(20);
        DIL_BEGIN(21);
#pragma unroll
        for (int j = 0; j < 16; ++j) if (j < ngrp) {
            if (j < nch) {
#pragma unroll
                for (int e = 0; e < 4; ++e) { const float u = v4[j][e] + cadd; int bi = ((int)(__float_as_uint(u) - Rbits)) >> 14; bi = bi < 0 ? 0 : (bi > 511 ? 511 : bi);
                    __hip_atomic_fetch_add(hist + bi, 1u, __ATOMIC_RELAXED, __HIP_MEMORY_SCOPE_WORKGROUP); }
            }
        }
        asm volatile("s_waitcnt lgkmcnt(0)" ::: "memory");
        DIL_END(21);
        DIL_BEGIN(22);
        int bstar; unsigned above;
        {
            const u32x4 h0 = ((LAS u32x4*)hist)[lane * 2], h1 = ((LAS u32x4*)hist)[lane * 2 + 1];
            const unsigned hb[8] = {h0.x, h0.y, h0.z, h0.w, h1.x, h1.y, h1.z, h1.w};
            const unsigned s = (h0.x + h0.y) + (h0.z + h0.w) + (h1.x + h1.y) + (h1.z + h1.w);
            const unsigned inc_ = scan_incl_u(s); const unsigned tot_ = (unsigned)__builtin_amdgcn_readlane((int)inc_, 63);
            const unsigned Tl = tot_ - inc_ + s;
            const unsigned long long bal = __ballot(Tl >= 256u);
            const int L = __popcll(bal) - 1;
            unsigned cab = Tl - s; int bst = 0; unsigned ab = 0; bool found = false;
#pragma unroll
            for (int j = 7; j >= 0; --j) { if (!found) { if (cab + hb[j] >= 256u) { bst = 8 * lane + j; ab = cab; found = true; } else cab += hb[j]; } }
            bstar = __builtin_amdgcn_readlane(bst, L); above = (unsigned)__builtin_amdgcn_readlane((int)ab, L);
        }
        DIL_END(22);
        DIL_BEGIN(23);
        const unsigned need = 256u - above;
        const unsigned UhiB = bstar < 511 ? Rbits + ((unsigned)(bstar + 1) << 14) : 0x7f800000u;
        const unsigned UloB = bstar > 0 ? Rbits + ((unsigned)bstar << 14) : 0u;
        unsigned nh[2] = {0u, 0u}, nl[2] = {0u, 0u};
#pragma unroll
        for (int j = 0; j < 16; ++j) {
            if (j < ngrp) {
#pragma unroll
                for (int e = 0; e < 4; ++e) { const unsigned ub = __float_as_uint(v4[j][e] + cadd);
                    nh[j >> 3] = __builtin_amdgcn_alignbit(nh[j >> 3], ub - UhiB, 31); nl[j >> 3] = __builtin_amdgcn_alignbit(nl[j >> 3], ub - UloB, 31); }
            } else { nh[j >> 3] = (nh[j >> 3] << 4) | 15u; nl[j >> 3] = (nl[j >> 3] << 4) | 15u; }
        }
        unsigned long long selm, canm;
        { const unsigned ge_hi0 = __builtin_bitreverse32(~nh[0]), ge_hi1 = __builtin_bitreverse32(~nh[1]), ge_lo0 = __builtin_bitreverse32(~nl[0]), ge_lo1 = __builtin_bitreverse32(~nl[1]);
          selm = ((((unsigned long long)ge_hi1) << 32) | ge_hi0) & validm; canm = ((((unsigned long long)(ge_lo1 & ~ge_hi1)) << 32) | (ge_lo0 & ~ge_hi0)) & validm; }
        const unsigned m = (unsigned)__builtin_amdgcn_readlane((int)scan_incl_u((unsigned)__popcll(canm)), 63);
        DIL_END(23);
        DIL_BEGIN(24);
        if (m > 256u) {
            DIL_BEGIN(27);
            const int nslot = n >> 6;
#define ROWAT(i) row[4 * ((16 * (i) + (lane >> 2)) ^ wave) + (lane & 3)]
            unsigned cur = 0;
#pragma unroll 1
            for (int bit = 31; bit >= 0; --bit) { const unsigned trial = cur | (1u << bit); unsigned cnt = 0;
#pragma unroll 1
                for (int i = 0; i < nslot; ++i) cnt += fkey(ROWAT(i)) >= trial ? 1u : 0u;
                cnt = wave_sum_u(cnt); if (cnt >= 256u) cur = trial; }
            unsigned cgt = 0;
#pragma unroll 1
            for (int i = 0; i < nslot; ++i) cgt += fkey(ROWAT(i)) > cur ? 1u : 0u;
            cgt = wave_sum_u(cgt);
            const unsigned needt = 256u - cgt; unsigned bs = 0, seen = 0;
#pragma unroll 1
            for (int i = 0; i < nslot; ++i) { const unsigned k = fkey(ROWAT(i)); const bool eq = k == cur;
                const unsigned long long me = __ballot(eq); const bool take = k > cur || (eq && seen + mbcnt64(me) < needt);
                const unsigned long long mt = __ballot(take);
                if (take) idxl[bs + mbcnt64(mt)] = (unsigned short)(i * 64 + lane);
                bs += (unsigned)__popcll(mt); seen += (unsigned)__popcll(me); }
#undef ROWAT
            DIL_END(27);
        } else {
            {
                DIL_BEGIN(25);
                unsigned tot; int off = exscan_u((unsigned)__popcll(selm), lane, tot);
                while (selm) { const int bit = __builtin_ctzll(selm); selm &= selm - 1ull; idxl[off++] = (unsigned short)(256 * (bit >> 2) + 4 * lane + (bit & 3)); }
                DIL_END(25);
            }
            if (m) {
                DIL_BEGIN(26);
                LAS float* candv = (LAS float*)hist; LAS unsigned short* candi = (LAS unsigned short*)(hist + 256);
                unsigned tot; int off = exscan_u((unsigned)__popcll(canm), lane, tot);
                while (canm) { const int bit = __builtin_ctzll(canm); canm &= canm - 1ull;
                    candv[off] = row[4 * ((64 * (bit >> 2) + lane) ^ wave) + (bit & 3)]; candi[off] = (unsigned short)(256 * (bit >> 2) + 4 * lane + (bit & 3)); ++off; }
                asm volatile("s_waitcnt lgkmcnt(0)" ::: "memory");
                if (m <= 64u) {
                    const bool ok = (unsigned)lane < m; const float cv = ok ? candv[ok ? lane : 0] : 0.f; const unsigned ci = ok ? candi[ok ? lane : 0] : 0u; unsigned rank = 0u;
                    for (unsigned k = 0; k < m; ++k) { const float vk = __uint_as_float((unsigned)__builtin_amdgcn_readlane((int)__float_as_uint(cv), (int)k)); const unsigned ik2 = (unsigned)__builtin_amdgcn_readlane((int)ci, (int)k);
                        rank += (vk > cv || (vk == cv && ik2 < ci)) ? 1u : 0u; }
                    const bool win = ok && rank < need;
                    const unsigned long long mw = __ballot(win);
                    if (win) idxl[above + mbcnt64(mw)] = (unsigned short)ci;
                } else {
                    float cv[4]; unsigned ci[4], rank[4];
#pragma unroll
                    for (int r = 0; r < 4; ++r) { const unsigned j = (unsigned)lane + 64u * r; const bool ok = j < m; cv[r] = ok ? candv[ok ? j : 0] : 0.f; ci[r] = ok ? candi[ok ? j : 0] : 0u; rank[r] = 0u; }
                    const int nr = (int)((m + 63u) >> 6);
#pragma unroll 4
                    for (unsigned k = 0; k < m; ++k) { const float vk = candv[k]; const unsigned ik2 = candi[k];
#pragma unroll
                        for (int r = 0; r < 4; ++r) rank[r] += (vk > cv[r] || (vk == cv[r] && ik2 < ci[r])) ? 1u : 0u; }
                    unsigned wbase = above;
#pragma unroll
                    for (int r = 0; r < 4; ++r) if (r < nr) {
                        const bool win = ((unsigned)lane + 64u * r) < m && rank[r] < need;
                        const unsigned long long mw = __ballot(win);
                        if (win) idxl[wbase + mbcnt64(mw)] = (unsigned short)ci[r];
                        wbase += (unsigned)__popcll(mw);
                    }
                }
                DIL_END(26);
            }
        }
        DIL_END(24);
    } else {
#pragma unroll
        for (int i = 0; i < 4; ++i) idxl[i * 64 + lane] = (unsigned short)((i * 64 + lane) < n ? (i * 64 + lane) : 0);
    }
    const int nsel = n > 256 ? 256 : n;
    asm volatile("s_waitcnt lgkmcnt(0)" ::: "memory");
    DIL_END(11);
    DIL_BEGIN(12);
    for (int rp = 0; rp < SUBREP(9); ++rp) {
        DIL_BEGIN(30);
        const int col = lane & 15, g = lane >> 4; const size_t tok = tokbase + t0 + wave;
        h16x8 qf[2];
#pragma unroll
        for (int s = 0; s < 2; ++s) { if (col < 8) qf[s] = *(const h16x8*)(F.QB + tok * 512 + col * 64 + 32 * s + 8 * g); else { qf[s] = (h16x8){0, 0, 0, 0, 0, 0, 0, 0}; } }
        const int ntile = nsel >> 4;
        const h16* kvb = F.KVB + tokbase * 128 + 8 * (lane & 15);
        h16x4 gbv[4];
#pragma unroll
        for (int dt = 0; dt < 4; ++dt) gbv[dt] = *(const h16x4*)(F.GB + tok * 512 + (col & 7) * 64 + 16 * dt + 4 * g);
        u32x4 st[16], sn[16];
#pragma unroll
        for (int i = 0; i < 16; ++i) { const int kidx = idxl[4 * i + (lane >> 4)]; st[i] = *(const u32x4*)(kvb + (size_t)kidx * 128); }
        LAS unsigned char* vst = (LAS unsigned char*)row;
#define SWZ(rr) ((((rr) & 7) << 1) | (((rr) >> 3) & 1))
        f32x4 O[4];
#pragma unroll
        for (int dt = 0; dt < 4; ++dt) O[dt] = (f32x4){0.f, 0.f, 0.f, 0.f};
        float mrun = -1.0e30f, lrun = 0.f;
#pragma unroll
        for (int pc = 0; pc < 4; ++pc) {
#pragma unroll
            for (int i = 0; i < 16; ++i) { const int rr = 4 * i + (lane >> 4); *(LAS u32x4*)(vst + rr * 256 + 16 * ((lane & 15) ^ SWZ(rr))) = st[i]; }
            if (pc + 1 < 4) {
#pragma unroll
                for (int i = 0; i < 16; ++i) { const int kidx = idxl[64 * (pc + 1) + 4 * i + (lane >> 4)]; sn[i] = *(const u32x4*)(kvb + (size_t)kidx * 128); }
            }
            asm volatile("s_waitcnt lgkmcnt(0)" ::: "memory");
            f32x4 S4[4];
#pragma unroll
            for (int tt = 0; tt < 4; ++tt) {
                const int rr = 16 * tt + col;
                const h16x8 a0 = *(const LAS h16x8*)(vst + rr * 256 + 16 * (g ^ SWZ(rr))), a1 = *(const LAS h16x8*)(vst + rr * 256 + 16 * ((4 + g) ^ SWZ(rr)));
                S4[tt] = (f32x4){0.f, 0.f, 0.f, 0.f};
                S4[tt] = __builtin_amdgcn_mfma_f32_16x16x32_f16(a0, qf[0], S4[tt], 0, 0, 0); S4[tt] = __builtin_amdgcn_mfma_f32_16x16x32_f16(a1, qf[1], S4[tt], 0, 0, 0);
            }
            float tm = -3.0e38f;
#pragma unroll
            for (int tt = 0; tt < 4; ++tt) { if (4 * pc + tt >= ntile) S4[tt] = (f32x4){-3.0e38f, -3.0e38f, -3.0e38f, -3.0e38f}; tm = fmaxf(fmaxf(tm, fmaxf(S4[tt][0], S4[tt][1])), fmaxf(S4[tt][2], S4[tt][3])); }
            tm = half_swap_max(x16_max(tm));
            if (__any(tm > mrun + 8.0f)) {
                const float mnew = fmaxf(mrun, tm), alpha = fexp2(mrun - mnew);
                mrun = mnew; lrun *= alpha;
#pragma unroll
                for (int dt = 0; dt < 4; ++dt) O[dt] = O[dt] * alpha;
            }
#pragma unroll
            for (int tt = 0; tt < 4; ++tt)
#pragma unroll
                for (int e = 0; e < 4; ++e) { S4[tt][e] = fexp2(S4[tt][e] - mrun); lrun += S4[tt][e]; }
#pragma unroll
            for (int kh = 0; kh < 2; ++kh) {
                u32x4 pw; pw.x = pkh(S4[2 * kh][0], S4[2 * kh][1]); pw.y = pkh(S4[2 * kh][2], S4[2 * kh][3]); pw.z = pkh(S4[2 * kh + 1][0], S4[2 * kh + 1][1]); pw.w = pkh(S4[2 * kh + 1][2], S4[2 * kh + 1][3]);
                const h16x8 pb = __builtin_bit_cast(h16x8, pw);
                const int i16 = lane & 15, qq = i16 >> 2, pp = i16 & 3;
                const int r0 = 32 * kh + 4 * g + qq, r1 = r0 + 16;
#pragma unroll
                for (int dt = 0; dt < 4; ++dt) {
                    const int ch = 8 + 2 * dt + (pp >> 1);
                    const s16x4 lo = __builtin_amdgcn_ds_read_tr16_b64_v4i16((LAS s16x4*)(vst + r0 * 256 + 16 * (ch ^ SWZ(r0)) + 8 * (pp & 1)));
                    const s16x4 hi = __builtin_amdgcn_ds_read_tr16_b64_v4i16((LAS s16x4*)(vst + r1 * 256 + 16 * (ch ^ SWZ(r1)) + 8 * (pp & 1)));
                    const h16x8 av = __builtin_bit_cast(h16x8, (__attribute__((ext_vector_type(8))) short){lo[0], lo[1], lo[2], lo[3], hi[0], hi[1], hi[2], hi[3]});
                    O[dt] = __builtin_amdgcn_mfma_f32_16x16x32_f16(av, pb, O[dt], 0, 0, 0);
                }
            }
            asm volatile("s_waitcnt lgkmcnt(0)" ::: "memory");
#pragma unroll
            for (int i = 0; i < 16; ++i) st[i] = sn[i];
        }
#undef SWZ
        DIL_END(30);
        lrun = half_swap_sum(x16_sum(lrun));
        const float inv = 1.0f / lrun;
        if (col < 8) {
#pragma unroll
            for (int dt = 0; dt < 4; ++dt) {
                const size_t off = tok * 512 + col * 64 + 16 * dt + 4 * g;
                const h16x4 gb = gbv[dt];
                u32x2 w; w.x = pkh(O[dt][0] * inv * (float)gb[0], O[dt][1] * inv * (float)gb[1]); w.y = pkh(O[dt][2] * inv * (float)gb[2], O[dt][3] * inv * (float)gb[3]);
                *(u32x2*)(F.YB + off) = w;
            }
        }
    }
    DIL_END(12);
    DIL_BEGIN(14);
    __syncthreads();
    DIL_END(14);
}

__device__ __forceinline__ void p2_branch_a(Frame& F) {
    LAS float* biasL = (LAS float*)F.lds;
    for (int i = F.tid; i < 8 * 448; i += NWAVES * 64) { const int hh_ = i / 448, y = i % 448; int di = 320 - y; di = (di > 256 ? 256 : di) + 256; biasL[i] = F.BIAS[hh_ * 513 + di]; }
    __syncthreads();
    for (int wu = F.vcu; wu < NBATCH * 8 * 8; wu += F.G) {
        const int b = wu >> 6, h = (wu >> 3) & 7, cg = wu & 7;
        attn_a_unit(F, b, h, cg * 8 + F.wave, biasL);
    }
    __syncthreads();
}
__device__ __forceinline__ void p2_branch_b(Frame& F) {
    LAS unsigned* mm = (LAS unsigned*)(F.lds + LDS_MM);
    if (F.tid < 32) mm[F.tid] = (F.tid & 15) < 8 ? 0xffffffffu : 0u;
    __syncthreads();
    int par = 0;
    if (F.G % NBATCH == 0) {
        const int per = F.G / NBATCH, b = F.vcu / per, cul = F.vcu % per, NQG = SEQ / 8;
        const int nround = (NQG + per - 1) / per;
        for (int i = nround - 1; i >= 0; --i) {
            const int qg = i * per + ((i & 1) ? (per - 1 - cul) : cul);
            if (qg < NQG) { dsa_unit(F, b, qg, par); par ^= 1; }
        }
    } else {
        const int NU = T / 8;
        for (int i = 0; i * F.G < NU; ++i) {
            const int cu = (i & 1) ? (F.G - 1 - F.vcu) : F.vcu;
            const int u = i * F.G + cu; if (u >= NU) break;
            dsa_unit(F, u & 7, u >> 3, par); par ^= 1;
        }
    }
}

__device__ __forceinline__ void p3_final(Frame& F, const h16* Y3) {
    const int gw = F.vcu * NWAVES + F.wave, NGW = F.G * NWAVES;
    f32x4 gv[4];
#pragma unroll
    for (int j = 0; j < 4; ++j) gv[j] = ((const f32x4*)F.g2)[F.lane + 64 * j];
    for (int m = gw; m < T; m += NGW) {
        const f32x4* xr = (const f32x4*)(F.x + (size_t)m * DM) + F.lane;
        const u32x2* yr = (const u32x2*)(Y3 + (size_t)m * DM) + F.lane;
        f32x4 v[4]; float s = 0.f;
#pragma unroll
        for (int j = 0; j < 4; ++j) { v[j] = __builtin_nontemporal_load(xr + 64 * j); const h16x4 y = __builtin_bit_cast(h16x4, __builtin_nontemporal_load(yr + 64 * j));
            v[j].x += (float)y[0]; v[j].y += (float)y[1]; v[j].z += (float)y[2]; v[j].w += (float)y[3];
            s += (v[j].x * v[j].x + v[j].y * v[j].y) + (v[j].z * v[j].z + v[j].w * v[j].w); }
        const float rs = 1.0f / sqrtf(wave_sum(s) * (1.0f / DM) + EPS);
        f32x4* orow = (f32x4*)(F.out + (size_t)m * DM) + F.lane;
#pragma unroll
        for (int j = 0; j < 4; ++j) __builtin_nontemporal_store(v[j] * rs * gv[j], orow + 64 * j);
    }
}

struct Args { const float* in[9]; float* out; unsigned char* ws; int ph_lo, ph_hi, li, pad; };
__global__ void __launch_bounds__(NWAVES * 64, 2) hybrid_fwd(Args args) {
    extern __shared__ __attribute__((aligned(16))) unsigned char lds[];
    Frame F;
    F.lds = (LAS unsigned char*)lds;
    F.tid = threadIdx.x; F.lane = F.tid & 63; F.wave = __builtin_amdgcn_readfirstlane(F.tid >> 6);
    F.G = gridDim.x; { const int bx = blockIdx.x; F.vcu = (F.G % 8 == 0) ? (bx % 8) * (F.G / 8) + bx / 8 : bx; }
    unsigned char* ws = args.ws;
    F.x = args.in[0]; F.g1 = args.in[1]; F.w_in = args.in[2]; F.bm = args.in[3]; F.relb = args.in[4]; F.wa = args.in[5]; F.wb = args.in[6]; F.wo = args.in[7]; F.g2 = args.in[8]; F.out = args.out;
    F.WIN = (h16*)(ws + WS_WIN); F.WA = (h16*)(ws + WS_WA); F.WB = (h16*)(ws + WS_WB); F.WOUT = (h16*)(ws + WS_WOUT);
    F.XN = (h16*)(ws + WS_XN); F.QA = (h16*)(ws + WS_QA); F.KA = (h16*)(ws + WS_KA); F.VAT = (h16*)(ws + WS_VAT); F.GA = (h16*)(ws + WS_GA); F.QB = (h16*)(ws + WS_QB); F.GB = (h16*)(ws + WS_GB);
    F.GTA = (h16*)(ws + WS_GTA); F.GTB = (h16*)(ws + WS_GTB); F.KVB = (h16*)(ws + WS_KVB); F.IQ = (h16*)(ws + WS_IQ); F.IK = (h16*)(ws + WS_IK);
    F.YA = (h16*)(ws + WS_YA); F.YB = (h16*)(ws + WS_YB); F.TMP = (h16*)(ws + WS_TMP); F.MERGED = (h16*)(ws + WS_MERGED); F.Y3 = (h16*)(ws + WS_Y3);
    F.IW = (float*)(ws + WS_IW); F.ROPEB = (float*)(ws + WS_ROPEB); F.ROPEI = (float*)(ws + WS_ROPEI); F.BIAS = (float*)(ws + WS_BIAS);
    for (int u = F.tid; u < (LDS_BYTES - LDSCTL_OFF) / 4; u += NWAVES * 64) ((LAS unsigned*)(F.lds + LDSCTL_OFF))[u] = 0u;
    __syncthreads();
    volatile LAS unsigned* MISC = (volatile LAS unsigned*)(F.lds + MISC_OFF);
    unsigned* barw = (unsigned*)(ws + WS_CTL) + CW_BAR + args.li * XCD_BAR_WORDS;
    XcdBarrier bar; bar.bar = barw; bar.x = 0; bar.st = nullptr;
    if (N_LAUNCHES != PER_PHASE) bar = xcd_barrier_post(barw, MISC + 8);
#define GRID_BAR() do { if (N_LAUNCHES != PER_PHASE) xcd_barrier(bar); } while (0)
    const int lo = args.ph_lo, hi = args.ph_hi;
#define IN(k) (lo <= (k) && (k) < hi)
#define BOTH(k) (IN(k) && IN((k) + 1))
    typedef const unsigned short* cbp;
    LAS unsigned char* xbw = F.lds + LDS_HIST + F.wave * 2560;
#define NREP(k) ((REP_PHASE) == (k) ? 2 : 1)
    if (IN(0)) for (int rep = 0; rep < NREP(0); ++rep) { DIL_BEGIN(0); p0_prologue(F); DIL_END(0); DIL_BEGIN(40); if (BOTH(0)) GRID_BAR(); DIL_END(40); }
    if (IN(1)) for (int rep = 0; rep < NREP(1); ++rep) {
        DIL_BEGIN(1);
        {
            pg8::Gemm g{(cbp)F.XN, (cbp)F.WIN, T, NMAIN, DM}; pg8::StaticOrder S; S.init(T, NMAIN, F.G, (int)blockIdx.x);
            epi::EpiProj E{F.QA, F.KA, F.GA, F.QB, F.GB, F.GTA, F.GTB, F.KVB, F.IQ, F.IK, F.IW, F.bm, F.ROPEB, F.ROPEI, xbw};
            pg8::gemm_phase<epi::EpiProj, pg8::StaticOrder, true, true>(F.lds, g, S, E);
        }
        {
            pg8::Gemm g{(cbp)(F.WIN + (size_t)NMAIN * DM), (cbp)F.XN, 512, T, DM}; pg8::StaticOrder S; S.init(512, T, F.G, (int)blockIdx.x);
            epi::EpiVT E{F.VAT};
            pg8::gemm_phase<epi::EpiVT, pg8::StaticOrder, true, true>(F.lds, g, S, E);
        }
        DIL_END(1);
        DIL_BEGIN(41);
        if (BOTH(1)) GRID_BAR();
        DIL_END(41);
    }
    if (IN(2)) {
        DIL_BEGIN(2);
        for (int rep = 0; rep < NREP(2); ++rep) p2_branch_a(F);
        DIL_END(2);
        DIL_BEGIN(3);
        for (int rep = 0; rep < NREP(6); ++rep) p2_branch_b(F);
        DIL_END(3);
        DIL_BEGIN(42);
        if (BOTH(2)) GRID_BAR();
        DIL_END(42);
    }
    if (IN(3)) for (int rep = 0; rep < NREP(3); ++rep) {
        DIL_BEGIN(4);
        {
            pg8::Gemm g{(cbp)F.YA, (cbp)F.WA, T, DM, 512}; pg8::StaticOrder S; S.init(T, DM, F.G, (int)blockIdx.x);
            epi::EpiGate<0> E{F.GTA, nullptr, F.TMP, xbw};
            pg8::gemm_phase<epi::EpiGate<0>, pg8::StaticOrder, true, true>(F.lds, g, S, E);
        }
        {
            pg8::Gemm g{(cbp)F.YB, (cbp)F.WB, T, DM, 512}; pg8::StaticOrder S; S.init(T, DM, F.G, (int)blockIdx.x);
            epi::EpiGate<1> E{F.TMP, F.GTB, F.MERGED, xbw};
            pg8::gemm_phase<epi::EpiGate<1>, pg8::StaticOrder, true, true>(F.lds, g, S, E);
        }
        DIL_END(4);
        DIL_BEGIN(43);
        if (BOTH(3)) GRID_BAR();
        DIL_END(43);
    }
    if (IN(4)) for (int rep = 0; rep < NREP(4); ++rep) {
        DIL_BEGIN(5);
        pg8::Gemm g{(cbp)F.MERGED, (cbp)F.WOUT, T, DM, DM}; pg8::StaticOrder S; S.init(T, DM, F.G, (int)blockIdx.x);
        epi::EpiPlain E{F.Y3, DM, xbw};
        pg8::gemm_phase<epi::EpiPlain, pg8::StaticOrder, true, true>(F.lds, g, S, E);
        DIL_END(5);
        DIL_BEGIN(44);
        if (BOTH(4)) GRID_BAR();
        DIL_END(44);
    }
    if (IN(5)) for (int rep = 0; rep < NREP(5); ++rep) { DIL_BEGIN(6); p3_final(F, F.Y3); DIL_END(6); }
#undef IN
#undef BOTH
#undef NREP
}

extern "C" void kernel_launch(void* const* d_in, const int* in_sizes, int n_in, void* d_out, int out_size, void* d_ws, size_t ws_size, hipStream_t stream) {
    static int grid = 0;
    if (grid == 0) {
        if (n_in != 9 || in_sizes[0] != T * DM || out_size != T * DM || ws_size < WS_END) { fprintf(stderr, "kernel_launch: unexpected shapes / workspace (n_in %d, in0 %d, out %d, ws %zu)\n", n_in, n_in > 0 ? in_sizes[0] : -1, out_size, ws_size); grid = -1; return; }
        int dev = 0, cus = 0, per_cu = 0;
        if (hipGetDevice(&dev) != hipSuccess || hipDeviceGetAttribute(&cus, hipDeviceAttributeMultiprocessorCount, dev) != hipSuccess) { fprintf(stderr, "kernel_launch: device query failed\n"); grid = -1; return; }
        if (hipFuncSetAttribute((const void*)hybrid_fwd, hipFuncAttributeMaxDynamicSharedMemorySize, LDS_BYTES) != hipSuccess) { fprintf(stderr, "kernel_launch: hipFuncSetAttribute failed\n"); grid = -1; return; }
        if (hipOccupancyMaxActiveBlocksPerMultiprocessor(&per_cu, (const void*)hybrid_fwd, NWAVES * 64, LDS_BYTES) != hipSuccess || per_cu < 1)
            fprintf(stderr, "kernel_launch: note: occupancy query reports %d workgroups per CU\n", per_cu);
        (void)hipGetLastError();
        grid = cus;
    }
    if (grid < 0) return;
    if (hipMemsetAsync((char*)d_ws + WS_CTL + (size_t)CW_BAR * 4, 0, (size_t)XCD_BAR_WORDS * 4, stream) != hipSuccess) { fprintf(stderr, "kernel_launch: memset failed\n"); return; }
    Args a{};
    for (int i = 0; i < 9; ++i) a.in[i] = (const float*)d_in[i];
    a.out = (float*)d_out; a.ws = (unsigned char*)d_ws;
    if (N_LAUNCHES == PER_PHASE) {
        for (int li = 0; li < PER_PHASE; ++li) { a.ph_lo = li; a.ph_hi = li + 1; a.li = 0; hipLaunchKernelGGL(hybrid_fwd, dim3(grid), dim3(NWAVES * 64), LDS_BYTES, stream, a); }
    } else {
        a.ph_lo = 0; a.ph_hi = PER_PHASE; a.li = 0;
        hipLaunchKernelGGL(hybrid_fwd, dim3(grid), dim3(NWAVES * 64), LDS_BYTES, stream, a);
    }
    const hipError_t le = hipPeekAtLastError();
    if (le != hipSuccess) fprintf(stderr, "kernel_launch: launch failed: %s\n", hipGetErrorName(le));
}
```

```cpp
#include <hip/hip_runtime.h>
#include <cstdio>
#include <cstdint>
#include <type_traits>

#ifndef REP_PHASE
#define REP_PHASE -1
#endif
#ifndef DIAG_SEL
#define DIAG_SEL -1
#endif
#define DIL_BEGIN(k) const unsigned long long dil_t0_##k = (DIAG_SEL == (k)) ? __builtin_amdgcn_s_memrealtime() : 0ull
#define DIL_END(k) do { if (DIAG_SEL == (k)) { const unsigned long long t1_ = __builtin_amdgcn_s_memrealtime(); const unsigned long long dt_ = t1_ - dil_t0_##k; \
    while (__builtin_amdgcn_s_memrealtime() - t1_ < dt_) __builtin_amdgcn_s_sleep(2); } } while (0)
namespace pg8 {
#define PG8_LAS __attribute__((address_space(3)))
typedef unsigned short bf16_t;
typedef _Float16 bf16x8 __attribute__((ext_vector_type(8)));
typedef float f32x4 __attribute__((ext_vector_type(4)));
typedef unsigned u32x4 __attribute__((ext_vector_type(4)));
constexpr int BM = 256, BK = 64, HALF = 128, HTB = HALF * BK * 2  , STAGE_BYTES = 8 * HTB, NXCD = 8, WGM = 8;

__host__ __device__ __forceinline__ int lds_byte(int r, int c) { const int st = (r >> 4) * 2 + (c >> 5), rr = r & 15, cc = c & 31, ob = rr * 64 + cc * 2; return st * 1024 + (ob ^ (((ob >> 9) & 1) << 5)); }
__host__ __device__ __forceinline__ void stage_rc(int b, int& R, int& C) { const int st = b / 1024, sb = b % 1024, swz = sb ^ (((sb >> 9) & 1) << 5); R = (st >> 1) * 16 + swz / 64; C = (st & 1) * 32 + (swz % 64) / 2; }
__host__ __device__ __forceinline__ int perm32(int rho) { const int n = rho >> 4, i = rho & 15; return 8 * (i >> 2) + 4 * n + (i & 3); }

struct Unit { int pm, pn; };
struct Gemm { const bf16_t* A; const bf16_t* Bt; int M, N, K; };

struct StaticOrder {
    int nM, nN, nwg, G, c;
    __host__ __device__ void init(int M, int N, int G_, int c_) { nM = M / BM; nN = N / BM; nwg = nM * nN; G = G_; c = c_; }
    __host__ __device__ bool next(int i, Unit& u) const {
        const long L = (long)i * G + c; if (L >= nwg) return false;
        int wgid = (int)L; { const int q = nwg / NXCD, r = nwg % NXCD, xcd = wgid % NXCD, off = wgid / NXCD; wgid = (xcd < r ? xcd * (q + 1) : r * (q + 1) + (xcd - r) * q) + off; }
        const int nig = WGM * nN, gid = wgid / nig, fm = gid * WGM, gsz = (nM - fm) < WGM ? (nM - fm) : WGM;
        u.pm = fm + ((wgid % nig) % gsz); u.pn = (wgid % nig) / gsz; return true;
    }
    __device__ __forceinline__ void a_ready(const Unit&) const {}
    __device__ __forceinline__ void done(const Unit&) const {}
};


template <class E> struct pg8_keep { static __device__ __forceinline__ bool f(const Unit&) { return false; } };

template <bool BF> __device__ __forceinline__ f32x4 pg8_mma(bf16x8 a, bf16x8 b, f32x4 c) {
    if constexpr (BF) { typedef __bf16 bfv8 __attribute__((ext_vector_type(8))); return __builtin_amdgcn_mfma_f32_16x16x32_bf16(__builtin_bit_cast(bfv8, a), __builtin_bit_cast(bfv8, b), c, 0, 0, 0); }
    else return __builtin_amdgcn_mfma_f32_16x16x32_f16(a, b, c, 0, 0, 0);
}

template <class Epi, class Sched, bool ALIGN_EPI = false, bool SP2 = false, bool BF = false>
__device__ __forceinline__ void gemm_phase(PG8_LAS unsigned char* lds, const Gemm g, const Sched& S, const Epi& E) {
    const int tid = threadIdx.x, wid = __builtin_amdgcn_readfirstlane(tid >> 6), lane = tid & 63, wr = wid >> 2, wc = wid & 3, fr = lane & 15, fq = lane >> 4;
    const int K = g.K, nt = K / BK;
    unsigned voffA[2], voffB[2];
#pragma unroll
    for (int i = 0; i < 2; ++i) { int R, C; stage_rc(tid * 16 + i * 8192, R, C); const int Rb = Epi::PERM ? ((R & ~31) + perm32(R & 31)) : R;
        voffA[i] = (unsigned)(R * K + C) * 2u; voffB[i] = (unsigned)(Rb * K + C) * 2u; }
    const size_t kstep = (size_t)(BK * 2);
    const size_t hstep = (size_t)HALF * K * 2;
    const size_t tstep = 2 * hstep;
    const unsigned ldsw = (unsigned)wid * 1024u;
    const int aoff = lds_byte(wr * 64 + fr, fq * 8), boff = lds_byte(wc * 32 + fr, fq * 8);
#define PG8_SA(b, h) (((b) * 2 + (h)) * HTB)
#define PG8_SB(b, h) ((4 + (b) * 2 + (h)) * HTB)
#define PG8_STAGE(bufoff, gbase, voff) do { _Pragma("unroll") for (int _i = 0; _i < 2; ++_i) \
        __builtin_amdgcn_global_load_lds((const unsigned*)((const char*)(gbase) + (voff)[_i]), (PG8_LAS unsigned*)(lds + (bufoff) + ldsw + _i * 8192), 16, 0, 0); } while (0)
#define PG8_LDA(dst, b, h) do { _Pragma("unroll") for (int m = 0; m < 4; ++m) _Pragma("unroll") for (int k = 0; k < 2; ++k) dst[m][k] = *(const PG8_LAS bf16x8*)(lds + PG8_SA(b, h) + aoff + m * 2048 + k * 1024); } while (0)
#define PG8_LDB(dst, b, h) do { _Pragma("unroll") for (int n = 0; n < 2; ++n) _Pragma("unroll") for (int k = 0; k < 2; ++k) dst[n][k] = *(const PG8_LAS bf16x8*)(lds + PG8_SB(b, h) + boff + n * 2048 + k * 1024); } while (0)
#define PG8_MMA(ai, bj, At, Bt) do { __builtin_amdgcn_s_setprio(1); _Pragma("unroll") for (int m = 0; m < 4; ++m) _Pragma("unroll") for (int n = 0; n < 2; ++n) _Pragma("unroll") for (int k = 0; k < 2; ++k) \
        acc[ai][bj][m][n] = pg8_mma<BF>(Bt[n][k], At[m][k], acc[ai][bj][m][n]); __builtin_amdgcn_s_setprio(0); } while (0)
#define PG8_WAIT_V(n) asm volatile("s_waitcnt vmcnt(" #n ")" ::: "memory")
#define PG8_WAIT_L(n) asm volatile("s_waitcnt lgkmcnt(" #n ")" ::: "memory")
#define PG8_BAR __builtin_amdgcn_s_barrier()
#define PG8_SCHED __builtin_amdgcn_sched_barrier(0)
    Unit cur, nxt; int ui = 0;
    if (!S.next(0, cur)) return;
    f32x4 acc[2][2][4][2];
#pragma unroll
    for (int a = 0; a < 2; ++a)
#pragma unroll
        for (int b = 0; b < 2; ++b)
#pragma unroll
            for (int m = 0; m < 4; ++m)
#pragma unroll
                for (int n = 0; n < 2; ++n) acc[a][b][m][n] = (f32x4){0.f, 0.f, 0.f, 0.f};
    bf16x8 At[4][2], B0[2][2], B1[2][2];
    const char* cA = (const char*)g.A + (size_t)cur.pm * tstep; const char* cB = (const char*)g.Bt + (size_t)cur.pn * tstep;
    S.a_ready(cur);
    if constexpr (SP2) {
        PG8_STAGE(PG8_SB(0, 0), cB, voffB); PG8_STAGE(PG8_SB(0, 1), cB + hstep, voffB); PG8_STAGE(PG8_SA(0, 0), cA, voffA); PG8_STAGE(PG8_SA(0, 1), cA + hstep, voffA);
        if (wr == 1) PG8_BAR;
        PG8_WAIT_V(2); PG8_BAR;
        PG8_STAGE(PG8_SB(1, 0), cB + kstep, voffB); PG8_STAGE(PG8_SA(1, 0), cA + kstep, voffA); PG8_STAGE(PG8_SB(1, 1), cB + hstep + kstep, voffB);
        PG8_WAIT_V(6); PG8_BAR;
    } else {
        PG8_STAGE(PG8_SB(0, 0), cB, voffB); PG8_STAGE(PG8_SA(0, 0), cA, voffA); PG8_STAGE(PG8_SB(0, 1), cB + hstep, voffB); PG8_STAGE(PG8_SA(0, 1), cA + hstep, voffA);
        if (wr == 1) PG8_BAR;
        PG8_WAIT_V(4); PG8_BAR;
        PG8_STAGE(PG8_SB(1, 0), cB + kstep, voffB); PG8_STAGE(PG8_SA(1, 0), cA + kstep, voffA); PG8_STAGE(PG8_SB(1, 1), cB + hstep + kstep, voffB);
        PG8_WAIT_V(6); PG8_BAR;
    }
    for (;;) {
        const bool has_next = S.next(ui + 1, nxt);
        const char* nA = has_next ? (const char*)g.A + (size_t)nxt.pm * tstep : cA; const char* nB = has_next ? (const char*)g.Bt + (size_t)nxt.pn * tstep : cB;
        for (int t = 0; t < nt; t += 2) {
            const bool last = (t == nt - 2);
            const char* a1 = cA + (size_t)(t + 1) * kstep;
            const char* a2 = last ? nA : cA + (size_t)(t + 2) * kstep; const char* b2 = last ? nB : cB + (size_t)(t + 2) * kstep;
            const char* a3 = a2 + kstep; const char* b3 = b2 + kstep;
            if (last && has_next) S.a_ready(nxt);
            if constexpr (SP2) {
            PG8_LDB(B0, 0, 0); PG8_LDB(B1, 0, 1); PG8_SCHED; PG8_LDA(At, 0, 0); PG8_STAGE(PG8_SA(1, 1), a1 + hstep, voffA);
            PG8_WAIT_V(8); PG8_WAIT_L(0); PG8_BAR; PG8_MMA(0, 0, At, B0); PG8_MMA(0, 1, At, B1); PG8_BAR; PG8_SCHED;
            PG8_LDA(At, 0, 1); PG8_STAGE(PG8_SB(0, 0), b2, voffB); PG8_STAGE(PG8_SB(0, 1), b2 + hstep, voffB); PG8_STAGE(PG8_SA(0, 0), a2, voffA);
            PG8_WAIT_V(8); PG8_WAIT_L(0); PG8_BAR; PG8_MMA(1, 0, At, B0); PG8_MMA(1, 1, At, B1); PG8_BAR; PG8_SCHED;
            PG8_LDB(B0, 1, 0); PG8_LDB(B1, 1, 1); PG8_SCHED; PG8_LDA(At, 1, 0); PG8_STAGE(PG8_SA(0, 1), a2 + hstep, voffA);
            PG8_WAIT_V(8); PG8_WAIT_L(0); PG8_BAR; PG8_MMA(0, 0, At, B0); PG8_MMA(0, 1, At, B1); PG8_BAR; PG8_SCHED;
            PG8_LDA(At, 1, 1); PG8_STAGE(PG8_SB(1, 0), b3, voffB); PG8_STAGE(PG8_SB(1, 1), b3 + hstep, voffB); PG8_STAGE(PG8_SA(1, 0), a3, voffA);
            PG8_WAIT_V(8); PG8_WAIT_L(0); PG8_BAR; PG8_MMA(1, 0, At, B0); PG8_MMA(1, 1, At, B1); PG8_BAR; PG8_SCHED;
            } else {
            PG8_LDB(B0, 0, 0); PG8_SCHED; PG8_LDA(At, 0, 0); PG8_STAGE(PG8_SA(1, 1), a1 + hstep, voffA);
            PG8_WAIT_L(8); PG8_BAR; PG8_WAIT_L(0); PG8_MMA(0, 0, At, B0); PG8_BAR; PG8_SCHED;
            PG8_LDB(B1, 0, 1); PG8_STAGE(PG8_SB(0, 0), b2, voffB);
            PG8_BAR; PG8_WAIT_L(0); PG8_MMA(0, 1, At, B1); PG8_BAR;
            PG8_LDA(At, 0, 1); PG8_STAGE(PG8_SA(0, 0), a2, voffA);
            PG8_BAR; PG8_WAIT_L(0); PG8_MMA(1, 0, At, B0); PG8_BAR; PG8_SCHED;
            PG8_STAGE(PG8_SB(0, 1), b2 + hstep, voffB);
            PG8_WAIT_V(6); PG8_BAR; PG8_MMA(1, 1, At, B1); PG8_BAR;
            PG8_LDB(B0, 1, 0); PG8_SCHED; PG8_LDA(At, 1, 0); PG8_STAGE(PG8_SA(0, 1), a2 + hstep, voffA);
            PG8_WAIT_L(8); PG8_BAR; PG8_WAIT_L(0); PG8_MMA(0, 0, At, B0); PG8_BAR; PG8_SCHED;
            PG8_LDB(B1, 1, 1); PG8_STAGE(PG8_SB(1, 0), b3, voffB);
            PG8_BAR; PG8_WAIT_L(0); PG8_MMA(0, 1, At, B1); PG8_BAR;
            PG8_LDA(At, 1, 1); PG8_STAGE(PG8_SA(1, 0), a3, voffA);
            PG8_BAR; PG8_WAIT_L(0); PG8_MMA(1, 0, At, B0); PG8_BAR; PG8_SCHED;
            PG8_STAGE(PG8_SB(1, 1), b3 + hstep, voffB);
            PG8_WAIT_V(6); PG8_BAR; PG8_MMA(1, 1, At, B1); PG8_BAR;
            }
        }
        if constexpr (ALIGN_EPI) { if (wr == 0) PG8_BAR; }
        if constexpr (!Epi::AFTER_DRAIN) { DIL_BEGIN(50); E(acc, cur, wr, wc, fr, fq); DIL_END(50); S.done(cur); }
        if (!has_next) break;
        if (!pg8_keep<Epi>::f(cur))
#pragma unroll
        for (int a = 0; a < 2; ++a)
#pragma unroll
            for (int b = 0; b < 2; ++b)
#pragma unroll
                for (int m = 0; m < 4; ++m)
#pragma unroll
                    for (int n = 0; n < 2; ++n) acc[a][b][m][n] = (f32x4){0.f, 0.f, 0.f, 0.f};
        cur = nxt; cA = nA; cB = nB; ++ui;
        if constexpr (ALIGN_EPI) { if (wr == 1) PG8_BAR; }
    }
    PG8_WAIT_V(0);
    if constexpr (!ALIGN_EPI) { if (wr == 0) PG8_BAR; }
    PG8_BAR;
    if constexpr (Epi::AFTER_DRAIN) { E.fused(acc, cur, wr, wc, fr, fq, lds, wid, lane); S.done(cur); }
#undef PG8_SA
#undef PG8_SB
#undef PG8_STAGE
#undef PG8_LDA
#undef PG8_LDB
#undef PG8_MMA
#undef PG8_WAIT_V
#undef PG8_WAIT_L
#undef PG8_BAR
#undef PG8_SCHED
}
}


#define LAS __attribute__((address_space(3)))
#define GAS __attribute__((address_space(1)))
typedef _Float16 h16;
typedef _Float16 h16x8 __attribute__((ext_vector_type(8)));
typedef _Float16 h16x4 __attribute__((ext_vector_type(4)));
typedef _Float16 h16x2 __attribute__((ext_vector_type(2)));
typedef float f32x2 __attribute__((ext_vector_type(2)));
typedef float f32x4 __attribute__((ext_vector_type(4)));
typedef float f32x16 __attribute__((ext_vector_type(16)));
typedef unsigned u32x4 __attribute__((ext_vector_type(4)));
typedef unsigned u32x2 __attribute__((ext_vector_type(2)));
typedef short s16x4 __attribute__((ext_vector_type(4)));

constexpr int NWAVES = 8;
constexpr int DM = 1024, NBATCH = 8, SEQ = 4096, T = NBATCH * SEQ, INW = 5544;
constexpr int NPHYS = 5632;
constexpr int NMAIN = 5120;
constexpr float EPS = 1e-6f;
constexpr float LOG2E = 1.4426950408889634f;
constexpr float QSCALE = 0.125f * LOG2E;
#ifndef MK_N_LAUNCHES
#define MK_N_LAUNCHES 1
#endif
constexpr int N_LAUNCHES = MK_N_LAUNCHES;
constexpr int PER_PHASE = 6;

constexpr size_t MiB = 1u << 20;
constexpr size_t WS_CTL = 0, CTL_ZERO_BYTES = 1 * MiB;
constexpr size_t WS_WIN = 2 * MiB, WS_WA = 13 * MiB, WS_WB = 14 * MiB, WS_WOUT = 15 * MiB;
constexpr size_t WS_ROPEB = 17 * MiB, WS_ROPEI = WS_ROPEB + 256 * 1024, WS_BIAS = WS_ROPEI + 128 * 1024;
constexpr size_t WS_IW = 18 * MiB, WS_IK = 19 * MiB, WS_KVB = 21 * MiB, WS_IQ = 29 * MiB;
constexpr size_t WS_XN = 48 * MiB;
constexpr size_t WS_QA = 112 * MiB, WS_KA = 144 * MiB, WS_VAT = 176 * MiB, WS_GA = 210 * MiB, WS_QB = 242 * MiB, WS_GB = 274 * MiB;
constexpr size_t WS_GTA = 306 * MiB, WS_GTB = 370 * MiB, WS_END = 434 * MiB;
constexpr size_t WS_YA = WS_XN, WS_YB = WS_XN + 32 * MiB, WS_TMP = WS_QA, WS_MERGED = WS_GA, WS_Y3 = WS_GTA;
constexpr int CW_BAR = 4096;

constexpr int RING_BYTES = 131072;
constexpr int LDS_HIST = 131072, LDS_IDX = LDS_HIST + 8 * 2048, LDSCTL_OFF = LDS_IDX + 8 * 512, MISC_OFF = LDSCTL_OFF + 320, LDS_MM = LDSCTL_OFF + 512, LDS_TC = LDSCTL_OFF + 640;
constexpr int LDS_PRE = LDSCTL_OFF + 1024;
constexpr int LDS_BYTES = LDS_PRE + 8 * 528 + 256;

__device__ __forceinline__ unsigned pkh(float lo, float hi) { f32x2 v = {lo, hi}; h16x2 h = __builtin_convertvector(v, h16x2); return __builtin_bit_cast(unsigned, h); }
typedef __bf16 bf16x2_t __attribute__((ext_vector_type(2)));
__device__ __forceinline__ unsigned pkb(float lo, float hi) { f32x2 v = {lo, hi}; bf16x2_t h = __builtin_convertvector(v, bf16x2_t); return __builtin_bit_cast(unsigned, h); }
#ifndef P1_BF16
#define P1_BF16 1
#endif
__device__ __forceinline__ unsigned pk1(float lo, float hi) { return P1_BF16 ? pkb(lo, hi) : pkh(lo, hi); }
__device__ __forceinline__ float fexp2(float x) { return __builtin_amdgcn_exp2f(x); }
__device__ __forceinline__ float frcp(float x) { return __builtin_amdgcn_rcpf(x); }
__device__ __forceinline__ float sigmoidf_(float v) { return frcp(1.0f + fexp2(-v * LOG2E)); }
__device__ __forceinline__ float siluf_(float v) { return v * sigmoidf_(v); }
__device__ __forceinline__ float wave_sum(float v) {
#pragma unroll
    for (int o = 1; o < 64; o <<= 1) v += __shfl_xor(v, o);
    return v;
}
__device__ __forceinline__ float wave_max(float v) {
#pragma unroll
    for (int o = 1; o < 64; o <<= 1) v = fmaxf(v, __shfl_xor(v, o));
    return v;
}
__device__ __forceinline__ float wave_min(float v) {
#pragma unroll
    for (int o = 1; o < 64; o <<= 1) v = fminf(v, __shfl_xor(v, o));
    return v;
}
__device__ __forceinline__ unsigned wave_sum_u(unsigned v) {
#pragma unroll
    for (int o = 1; o < 64; o <<= 1) v += __shfl_xor(v, o);
    return v;
}

namespace epi {
using pg8::Unit;
__device__ __forceinline__ void store8(h16* p, const f32x4& a, const f32x4& b) {
    u32x4 w; w.x = pkh(a[0], a[1]); w.y = pkh(a[2], a[3]); w.z = pkh(b[0], b[1]); w.w = pkh(b[2], b[3]); *(u32x4*)p = w;
}
__device__ __forceinline__ u32x4 xch_rows(LAS unsigned char* xb, const u32x4 v, int lane) {
    *(LAS u32x4*)(xb + (lane & 15) * 80 + (lane >> 4) * 16) = v;
    return *(const LAS u32x4*)(xb + (lane >> 2) * 80 + (lane & 3) * 16);
}
__device__ __forceinline__ size_t afrag(int row, int hd, int dc) {
    const int b = row >> 12, pos = row & (SEQ - 1);
    return ((((((size_t)(b * 8 + hd) * 64 + (pos >> 6)) * 2 + ((pos >> 5) & 1)) * 4 + (dc >> 1)) * 2 + (dc & 1)) * 32 + (pos & 31)) * 8;
}
__device__ __forceinline__ void xch_rows2(LAS unsigned char* xb, const u32x4 a, const u32x4 b, int lane, u32x4& ra, u32x4& rb) {
    *(LAS u32x4*)(xb + (lane & 15) * 80 + (lane >> 4) * 16) = a;
    *(LAS u32x4*)(xb + 1280 + (lane & 15) * 80 + (lane >> 4) * 16) = b;
    ra = *(const LAS u32x4*)(xb + (lane >> 2) * 80 + (lane & 3) * 16);
    rb = *(const LAS u32x4*)(xb + 1280 + (lane >> 2) * 80 + (lane & 3) * 16);
}
__device__ __forceinline__ u32x4 xch_frag(LAS unsigned char* xb, const u32x4 v, int lane) {
    *(LAS u32x4*)(xb + (lane >> 2) * 80 + (lane & 3) * 16) = v;
    return *(const LAS u32x4*)(xb + (lane & 15) * 80 + (lane >> 4) * 16);
}
__device__ __forceinline__ void st_nt(void* p, const u32x4 v) { __builtin_nontemporal_store(v, (u32x4*)p); }
__device__ __forceinline__ u32x4 ld_nt(const void* p) { return __builtin_nontemporal_load((const u32x4*)p); }
__device__ __forceinline__ u32x4 pack8(const f32x4& a, const f32x4& b) { u32x4 w; w.x = pkh(a[0], a[1]); w.y = pkh(a[2], a[3]); w.z = pkh(b[0], b[1]); w.w = pkh(b[2], b[3]); return w; }
__device__ __forceinline__ void rope4(f32x4& v0, f32x4& v1, const float* tab) {
    const f32x4 t0 = *(const f32x4*)tab, t1 = *(const f32x4*)(tab + 4);
    float a, b;
    a = v0[0]; b = v0[1]; v0[0] = a * t0[0] - b * t0[1]; v0[1] = b * t0[0] + a * t0[1];
    a = v0[2]; b = v0[3]; v0[2] = a * t0[2] - b * t0[3]; v0[3] = b * t0[2] + a * t0[3];
    a = v1[0]; b = v1[1]; v1[0] = a * t1[0] - b * t1[1]; v1[1] = b * t1[0] + a * t1[1];
    a = v1[2]; b = v1[3]; v1[2] = a * t1[2] - b * t1[3]; v1[3] = b * t1[2] + a * t1[3];
}
__device__ __forceinline__ void rope4v(f32x4& v0, f32x4& v1, const f32x4 t0, const f32x4 t1) {
    float a, b;
    a = v0[0]; b = v0[1]; v0[0] = a * t0[0] - b * t0[1]; v0[1] = b * t0[0] + a * t0[1];
    a = v0[2]; b = v0[3]; v0[2] = a * t0[2] - b * t0[3]; v0[3] = b * t0[2] + a * t0[3];
    a = v1[0]; b = v1[1]; v1[0] = a * t1[0] - b * t1[1]; v1[1] = b * t1[0] + a * t1[1];
    a = v1[2]; b = v1[3]; v1[2] = a * t1[2] - b * t1[3]; v1[3] = b * t1[2] + a * t1[3];
}
__device__ __forceinline__ size_t fragoff(int pm, int j, int wr, int wc, int ix, int lane) { return (((((size_t)(pm * 4 + j) * 8 + (wr * 4 + wc)) * 16 + ix) * 64) + lane) * 8; }
struct EpiProj {
    static constexpr bool PERM = true, AFTER_DRAIN = false;
    h16 *QA, *KA, *GA, *QB, *GB, *GTA, *GTB, *KVB, *IQ, *IK; float* IW; const float* bm; const float* ropeb; const float* ropei; LAS unsigned char* xb;
    __device__ __forceinline__ void operator()(const f32x4 (&acc)[2][2][4][2], const Unit& u, int wr, int wc, int fr, int fq) const {
        const int pn = u.pn, row0 = u.pm * 256 + wr * 64 + fr;
        const int lane = fq * 16 + fr, rowx0 = u.pm * 256 + wr * 64 + (lane >> 2), clx = wc * 32 + 8 * (lane & 3);
        if (pn < 18) {
            h16* base; int ldc, colt, kind; const float* bias = nullptr;
            if (pn < 2) { base = QA; ldc = 512; colt = 256 * pn; kind = 1; }
            else if (pn < 4) { base = KA; ldc = 512; colt = 256 * (pn - 2); kind = 0; }
            else if (pn < 6) { base = GA; ldc = 512; colt = 256 * (pn - 4); kind = 2; }
            else if (pn < 8) { base = QB; ldc = 512; colt = 256 * (pn - 6); kind = 4; }
            else if (pn < 10) { base = GB; ldc = 512; colt = 256 * (pn - 8); kind = 2; }
            else if (pn < 14) { base = GTA; ldc = 1024; colt = 256 * (pn - 10); kind = 3; bias = bm + colt; }
            else { base = GTB; ldc = 1024; colt = 256 * (pn - 14); kind = 3; bias = bm + 1024 + colt; }
            const int cl = wc * 32 + 8 * fq;
            f32x4 bv[2][2];
#pragma unroll
            for (int bj = 0; bj < 2; ++bj)
#pragma unroll
                for (int n = 0; n < 2; ++n) bv[bj][n] = (kind == 3) ? *(const f32x4*)(bias + bj * 128 + cl + 4 * n) : (f32x4){0.f, 0.f, 0.f, 0.f};
            const bool ropel = (kind == 4) && ((wc & 1) == 0) && (fq < 2);
            const bool afr = pn < 2 || pn == 4 || pn == 5;
#pragma unroll
            for (int ai = 0; ai < 2; ++ai) {
                f32x4 rt[4][2];
                if (ropel) {
#pragma unroll
                    for (int m = 0; m < 4; ++m) { const float* tab = ropeb + (size_t)((row0 + ai * 128 + m * 16) & (SEQ - 1)) * 16 + fq * 8; rt[m][0] = *(const f32x4*)tab; rt[m][1] = *(const f32x4*)(tab + 4); }
                }
#pragma unroll
                for (int m = 0; m < 4; ++m) {
                    const int row = row0 + ai * 128 + m * 16;
                    h16* rowp = base + (size_t)(rowx0 + ai * 128 + m * 16) * ldc + colt + clx;
                    const int kpos = row & (SEQ - 1), kslot = (kpos & 19) | ((kpos & 4) << 1) | ((kpos & 8) >> 1);
                    const size_t kbase = ((size_t)(row >> 12) * 8) * 128 + (size_t)(kpos >> 5);
                    u32x4 pk2[2] = {(u32x4){0u, 0u, 0u, 0u}, (u32x4){0u, 0u, 0u, 0u}};
#pragma unroll
                    for (int bj = 0; bj < 2; ++bj) {
                        f32x4 v0 = acc[ai][bj][m][0], v1 = acc[ai][bj][m][1];
                        if (kind == 1) { v0 = v0 * QSCALE; v1 = v1 * QSCALE; }
                        else if (kind == 2) {
#pragma unroll
                            for (int e = 0; e < 4; ++e) { v0[e] = siluf_(v0[e]); v1[e] = siluf_(v1[e]); }
                        } else if (kind == 3) {
                            v0 = v0 + bv[bj][0]; v1 = v1 + bv[bj][1];
#pragma unroll
                            for (int e = 0; e < 4; ++e) { v0[e] = sigmoidf_(v0[e]); v1[e] = sigmoidf_(v1[e]); }
                        } else if (kind == 4) {
                            if (ropel) rope4v(v0, v1, rt[m][0], rt[m][1]);
                            v0 = v0 * QSCALE; v1 = v1 * QSCALE;
                        }
                        if (pn == 2 || pn == 3) {
                            const int cc = colt + bj * 128 + cl, hd = cc >> 6, dc = (cc & 63) >> 3;
                            st_nt(KA + (((kbase + (size_t)hd * 128) * 8 + dc) * 32 + kslot) * 8, pack8(v0, v1));
                        } else if (kind == 3) st_nt(base + fragoff(u.pm, (pn - 10) & 3, wr, wc, (ai * 4 + m) * 2 + bj, lane), pack8(v0, v1));
                        else if (afr) { const int cc = colt + bj * 128 + cl; st_nt(base + afrag(row, cc >> 6, (cc & 63) >> 3), pack8(v0, v1)); }
                        else pk2[bj] = pack8(v0, v1);
                    }
                    if (pn != 2 && pn != 3 && kind != 3 && !afr) { u32x4 r0, r1; xch_rows2(xb, pk2[0], pk2[1], lane, r0, r1); st_nt(rowp, r0); st_nt(rowp + 128, r1); }
                }
            }
        } else {
#pragma unroll
            for (int bj = 0; bj < 2; ++bj) {
                const int G = (pn - 18) * 8 + bj * 4 + wc;
                if (G >= 14) continue;
#pragma unroll
                for (int ai = 0; ai < 2; ++ai) {
                    f32x4 rt[4][2]; u32x4 pkx = {0u, 0u, 0u, 0u};
                    const bool rb = G == 0 && fq < 2, ri = G >= 4 && G <= 12 && fq == 0;
                    if (rb || ri) {
#pragma unroll
                        for (int m = 0; m < 4; ++m) { const int pos_ = (row0 + ai * 128 + m * 16) & (SEQ - 1); const float* tab = rb ? ropeb + (size_t)pos_ * 16 + fq * 8 : ropei + (size_t)pos_ * 8;
                            rt[m][0] = *(const f32x4*)tab; rt[m][1] = *(const f32x4*)(tab + 4); }
                    }
#pragma unroll
                    for (int m = 0; m < 4; ++m) {
                        const int row = row0 + ai * 128 + m * 16;
                        f32x4 v0 = acc[ai][bj][m][0], v1 = acc[ai][bj][m][1];
                        if (G < 12) {
                            if ((G == 0 && fq < 2) || (G >= 4 && fq == 0)) rope4v(v0, v1, rt[m][0], rt[m][1]);
                            if ((m & 1) == 0) pkx = pack8(v0, v1);
                            else { u32x4 r0, r1; xch_rows2(xb, pkx, pack8(v0, v1), lane, r0, r1);
                                h16* p0 = G < 4 ? KVB + (size_t)(rowx0 + ai * 128 + (m - 1) * 16) * 128 + G * 32 + 8 * (lane & 3) : IQ + (size_t)(rowx0 + ai * 128 + (m - 1) * 16) * 256 + (G - 4) * 32 + 8 * (lane & 3);
                                *(u32x4*)p0 = r0; *(u32x4*)(p0 + (G < 4 ? 16 * 128 : 16 * 256)) = r1; }
                        } else if (G == 12) {
                            if (fq == 0) rope4v(v0, v1, rt[m][0], rt[m][1]);
                            store8(IK + ((((size_t)(row >> 4)) * 4 + fq) * 16 + (row & 15)) * 8, v0, v1);
                        } else {
                            if (fq == 0) { *(f32x4*)(IW + (size_t)row * 8) = v0 * 0.0625f; *(f32x4*)(IW + (size_t)row * 8 + 4) = v1 * 0.0625f; }
                        }
                    }
                }
            }
        }
    }
};
struct EpiVT {
    static constexpr bool PERM = true, AFTER_DRAIN = false;
    h16* VT;
    __device__ __forceinline__ void operator()(const f32x4 (&acc)[2][2][4][2], const Unit& u, int wr, int wc, int fr, int fq) const {
        const int row0 = u.pm * 256 + wr * 64 + fr, col0 = u.pn * 256 + wc * 32 + 8 * fq;
#pragma unroll
        for (int ai = 0; ai < 2; ++ai)
#pragma unroll
            for (int m = 0; m < 4; ++m) { const int R = row0 + ai * 128 + m * 16, hd = R >> 6, dd = R & 63;
#pragma unroll
                for (int bj = 0; bj < 2; ++bj) { const int tok = col0 + bj * 128, bb = tok >> 12, kg = (tok & (SEQ - 1)) >> 3;
                    st_nt(VT + ((((size_t)bb * 8 + hd) * 512 + kg) * 64 + dd) * 8, pack8(acc[ai][bj][m][0], acc[ai][bj][m][1])); } }
    }
};
struct EpiPlain {
    static constexpr bool PERM = true, AFTER_DRAIN = false;
    h16* C; int ldc; LAS unsigned char* xb;
    __device__ __forceinline__ void operator()(const f32x4 (&acc)[2][2][4][2], const Unit& u, int wr, int wc, int fr, int fq) const {
        const int lane = fq * 16 + fr, row0 = u.pm * 256 + wr * 64 + (lane >> 2), col0 = u.pn * 256 + wc * 32 + 8 * (lane & 3);
#pragma unroll
        for (int ai = 0; ai < 2; ++ai)
#pragma unroll
            for (int m = 0; m < 4; ++m) { h16* rowp = C + (size_t)(row0 + ai * 128 + m * 16) * ldc + col0;
                { u32x4 r0, r1; xch_rows2(xb, pack8(acc[ai][0][m][0], acc[ai][0][m][1]), pack8(acc[ai][1][m][0], acc[ai][1][m][1]), lane, r0, r1); *(u32x4*)rowp = r0; *(u32x4*)(rowp + 128) = r1; } }
    }
};
template <int MODE> struct EpiGate {
    static constexpr bool PERM = true, AFTER_DRAIN = false;
    const h16* G1; const h16* G2; h16* OUT; LAS unsigned char* xb;
    __device__ __forceinline__ void operator()(const f32x4 (&acc_)[2][2][4][2], const Unit& u, int wr, int wc, int fr, int fq) const {
        f32x4 (&acc)[2][2][4][2] = const_cast<f32x4 (&)[2][2][4][2]>(acc_);
        const int lane = fq * 16 + fr, row0 = u.pm * 256 + wr * 64 + (lane >> 2), col0 = u.pn * 256 + wc * 32 + 8 * (lane & 3);
        const size_t fo = fragoff(u.pm, u.pn, wr, wc, 0, lane);
        u32x4 gl[8], g2l[8]; u32x4 pkm = {0u, 0u, 0u, 0u};
#pragma unroll
        for (int hb = 0; hb < 2; ++hb) {
            if (MODE == 1) {
#pragma unroll
                for (int jx = 0; jx < 8; ++jx) g2l[jx] = ld_nt(G2 + fo + (size_t)(8 * hb + jx) * 512);
            }
#pragma unroll
            for (int jx = 0; jx < 8; ++jx) { const h16* p = G1 + fo + (size_t)(8 * hb + jx) * 512; gl[jx] = MODE == 0 ? ld_nt(p) : *(const u32x4*)p; }
            if (MODE == 1) {
#pragma unroll
                for (int jx = 0; jx < 8; ++jx) { const int ix = 8 * hb + jx, ai = ix >> 3, m = (ix >> 1) & 3, bj = ix & 1;
                    const h16x8 g2 = __builtin_bit_cast(h16x8, g2l[jx]);
#pragma unroll
                    for (int e = 0; e < 4; ++e) { acc[ai][bj][m][0][e] *= (float)g2[e]; acc[ai][bj][m][1][e] *= (float)g2[4 + e]; } }
            }
#pragma unroll
            for (int jx = 0; jx < 8; ++jx) { const int ix = 8 * hb + jx, ai = ix >> 3, m = (ix >> 1) & 3, bj = ix & 1;
                const h16x8 g1 = __builtin_bit_cast(h16x8, gl[jx]);
                f32x4 v0 = acc[ai][bj][m][0], v1 = acc[ai][bj][m][1];
                if (MODE == 0) {
#pragma unroll
                    for (int e = 0; e < 4; ++e) { v0[e] *= (float)g1[e]; v1[e] *= (float)g1[4 + e]; }
                    *(u32x4*)(OUT + fo + (size_t)ix * 512) = pack8(v0, v1);
                } else {
#pragma unroll
                    for (int e = 0; e < 4; ++e) { v0[e] += (float)g1[e]; v1[e] += (float)g1[4 + e]; }
                    if (bj == 0) pkm = pack8(v0, v1);
                    else { u32x4 r0, r1; xch_rows2(xb, pkm, pack8(v0, v1), lane, r0, r1); h16* rowp = OUT + (size_t)(row0 + ai * 128 + m * 16) * 1024 + col0; *(u32x4*)rowp = r0; *(u32x4*)(rowp + 128) = r1; }
                }
            }
        }
    }
};
}

typedef GAS unsigned gu32;
#define XB_TMO      128
#define XB_XCNT(j)  (256  + 64 * (j))
#define XB_XSUB(j)  (1280 + 64 * (j))
#define XB_XGEN(j)  (2304 + 64 * (j))
#define XB_TOP      3328
#define XB_TOPGEN   3392
#define XCD_BAR_WORDS 3456
#define XB_SPIN_CAP (1u << 18)
__device__ __forceinline__ unsigned xb_ld(unsigned* p)              { return __hip_atomic_load(p, __ATOMIC_RELAXED, __HIP_MEMORY_SCOPE_AGENT); }
__device__ __forceinline__ unsigned xb_add(unsigned* p, unsigned v) { return __hip_atomic_fetch_add(p, v, __ATOMIC_RELAXED, __HIP_MEMORY_SCOPE_AGENT); }
__device__ __forceinline__ unsigned xb_xcc_id() { return (unsigned)__builtin_amdgcn_s_getreg((3 << 11) | 20) & 0xFu; }
#define XB_SPIN(cond, bar) do { unsigned _sp = 0; while (cond) { __builtin_amdgcn_s_sleep(1); \
    if ((++_sp & 255u) == 0u) { if (xb_ld(&(bar)[XB_TMO])) break; if (_sp > XB_SPIN_CAP) { atomicAdd(&(bar)[XB_TMO], 1u); break; } } } } while (0)
struct XcdBarrier { unsigned* bar; unsigned x; volatile LAS unsigned* st; };
__device__ __forceinline__ XcdBarrier xcd_barrier_post(unsigned* bar, volatile LAS unsigned* st) {
    XcdBarrier b; b.bar = bar; b.x = xb_xcc_id(); b.st = st;
    if (threadIdx.x == 0) (void)xb_add(&bar[XB_XCNT(b.x)], 1u);
    return b;
}
__device__ __forceinline__ void xcd_barrier_complete(unsigned* bar, unsigned x, unsigned& nloc, unsigned& nx) {
    const unsigned G = gridDim.x * gridDim.y * gridDim.z;
    unsigned sum, cnt, mine, sp = 0u;
    for (;;) {
        sum = 0u; cnt = 0u; mine = 0u;
#pragma unroll
        for (unsigned j = 0; j < 16; ++j) { const unsigned c = xb_ld(&bar[XB_XCNT(j)]); sum += c; cnt += (c > 0u) ? 1u : 0u; mine = (j == x) ? c : mine; }
        if (sum == G) break;
        __builtin_amdgcn_s_sleep(1);
        if ((++sp & 255u) == 0u) { if (xb_ld(&bar[XB_TMO])) break; if (sp > XB_SPIN_CAP) { atomicAdd(&bar[XB_TMO], 1u); break; } }
    }
    nloc = mine > 0u ? mine : 1u; nx = cnt > 0u ? cnt : 1u;
}
__device__ __forceinline__ void xcd_barrier(const XcdBarrier& b) {
    asm volatile("s_waitcnt vmcnt(0)" ::: "memory");
    __syncthreads();
    if (threadIdx.x == 0) {
        unsigned* bar = b.bar;
        __builtin_amdgcn_s_waitcnt(0);
        unsigned nloc = b.st[0], nx = b.st[1];
        if (nloc == 0u) { xcd_barrier_complete(bar, b.x, nloc, nx); b.st[0] = nloc; b.st[1] = nx; }
        const unsigned old = xb_add(&bar[XB_XSUB(b.x)], 1u);
        const unsigned gen = old / nloc;
        if (old + 1u == (gen + 1u) * nloc) {
            __builtin_amdgcn_fence(__ATOMIC_RELEASE, "agent");
            asm volatile("s_waitcnt vmcnt(0)" ::: "memory");
            const unsigned og = xb_add(&bar[XB_TOP], 1u);
            const unsigned tg = og / nx;
            if (og + 1u == (tg + 1u) * nx) xb_add(&bar[XB_TOPGEN], 1u);
            else XB_SPIN(xb_ld(&bar[XB_TOPGEN]) == tg, bar);
            __builtin_amdgcn_fence(__ATOMIC_ACQUIRE, "agent");
            xb_add(&bar[XB_XGEN(b.x)], 1u);
            asm volatile("s_waitcnt vmcnt(0)" ::: "memory");
        } else {
            XB_SPIN(xb_ld(&bar[XB_XGEN(b.x)]) == gen, bar);
            __builtin_amdgcn_fence(__ATOMIC_ACQUIRE, "agent");
            asm volatile("s_waitcnt vmcnt(0)" ::: "memory");
        }
    }
    __syncthreads();
}

struct Frame {
    LAS unsigned char* lds; int tid, lane, wave, vcu, G;
    const float *x, *g1, *w_in, *bm, *relb, *wa, *wb, *wo, *g2; float* out;
    h16 *WIN, *WA, *WB, *WOUT, *XN, *QA, *KA, *VAT, *GA, *QB, *GB, *GTA, *GTB, *KVB, *IQ, *IK, *YA, *YB, *TMP, *MERGED, *Y3;
    float *IW, *ROPEB, *ROPEI, *BIAS;
    unsigned* dyn;
};

__device__ __forceinline__ int win_src_col(int j) {
    if (j < 1024) return j;
    if (j < 1536) return 1536 + (j - 1024);
    if (j < 2048) { const int o = j - 1536, hd = o >> 6, p = o & 63; const int lp = p < 16 ? ((p & 1) * 8 + (p >> 1)) : p; return 2048 + hd * 64 + lp; }
    if (j < 2560) return 2688 + (j - 2048);
    if (j < 3584) return 3496 + (j - 2560);
    if (j < 4608) return 4520 + (j - 3584);
    if (j < 5120) { const int o = j - 4608;
        if (o < 64) { const int lp = o < 16 ? ((o & 1) * 8 + (o >> 1)) : o; return 2560 + lp; }
        if (o < 128) return 2624 + (o - 64);
        if (o < 384) { const int q = o - 128, hd = q >> 5, p = q & 31; const int lp = p < 8 ? ((p & 1) * 4 + (p >> 1)) : p; return 3200 + hd * 32 + lp; }
        if (o < 416) { const int p = o - 384; const int lp = p < 8 ? ((p & 1) * 4 + (p >> 1)) : p; return 3456 + lp; }
        if (o < 424) return 3488 + (o - 416);
        return -1; }
    return 1024 + (j - 5120);
}
template <bool MAP> __device__ __forceinline__ void p0_transpose_item(const float* W, int K, int N, h16* WT, LAS float* scr, int item, int lane) {
    const int kblk = K / 64, nb = item / kblk, kb = item % kblk, k0 = 64 * kb, j0 = 32 * nb;
    const int src = MAP ? win_src_col(j0 + (lane & 31)) : (j0 + (lane & 31));
#pragma unroll
    for (int i = 0; i < 32; ++i) { const int kk = 2 * i + (lane >> 5); scr[kk * 33 + (lane & 31)] = (src >= 0) ? __builtin_nontemporal_load(W + (size_t)(k0 + kk) * N + src) : 0.f; }
    asm volatile("s_waitcnt lgkmcnt(0)" ::: "memory");
    const int c = lane & 7;
#pragma unroll
    for (int j = 0; j < 4; ++j) { const int n = (lane >> 3) + 8 * j; const LAS float* s = scr + (8 * c) * 33 + n;
        u32x4 o;
        if (MAP) { o.x = pk1(s[0 * 33], s[1 * 33]); o.y = pk1(s[2 * 33], s[3 * 33]); o.z = pk1(s[4 * 33], s[5 * 33]); o.w = pk1(s[6 * 33], s[7 * 33]); }
        else { o.x = pkh(s[0 * 33], s[1 * 33]); o.y = pkh(s[2 * 33], s[3 * 33]); o.z = pkh(s[4 * 33], s[5 * 33]); o.w = pkh(s[6 * 33], s[7 * 33]); }
        *(u32x4*)(WT + (size_t)(j0 + n) * K + k0 + 8 * c) = o; }
    asm volatile("s_waitcnt lgkmcnt(0)" ::: "memory");
}
__device__ __forceinline__ void sincos_acc(float angf, float& c, float& s) {
    const double a = (double)angf;
    const double k = rint(a * 0.63661977236758134308);
    const double r = (a - k * 1.5707963267948966192) - k * 6.123233995736766e-17;
    const double r2 = r * r;
    const double sp = r * (1.0 + r2 * (-1.0 / 6 + r2 * (1.0 / 120 + r2 * (-1.0 / 5040 + r2 * (1.0 / 362880 + r2 * (-1.0 / 39916800 + r2 * (1.0 / 6227020800.0 + r2 * (-1.0 / 1307674368000.0))))))));
    const double cp = 1.0 + r2 * (-0.5 + r2 * (1.0 / 24 + r2 * (-1.0 / 720 + r2 * (1.0 / 40320 + r2 * (-1.0 / 3628800 + r2 * (1.0 / 479001600.0 + r2 * (-1.0 / 87178291200.0 + r2 * (1.0 / 20922789888000.0))))))));
    const int q = ((int)(long long)k) & 3;
    const double sv = (q == 0) ? sp : (q == 1) ? cp : (q == 2) ? -sp : -cp;
    const double cv = (q == 0) ? cp : (q == 1) ? -sp : (q == 2) ? -cp : sp;
    c = (float)cv; s = (float)sv;
}
__device__ __forceinline__ void p0_prologue(Frame& F) {
    LAS float* scr = (LAS float*)(F.lds + F.wave * 16384);
    const int gw = F.vcu * NWAVES + F.wave, NGW = F.G * NWAVES;
    constexpr int I_IN = (NPHYS / 32) * (DM / 64), I_A = (DM / 32) * (512 / 64), I_O = (DM / 32) * (DM / 64);
    constexpr int NITEMS = I_IN + 2 * I_A + I_O;
    DIL_BEGIN(60);
    for (int it = gw; it < NITEMS; it += NGW) {
        int r = it;
        if (r < I_IN) { p0_transpose_item<true>(F.w_in, DM, INW, F.WIN, scr, r, F.lane); continue; } r -= I_IN;
        if (r < I_A) { p0_transpose_item<false>(F.wa, 512, DM, F.WA, scr, r, F.lane); continue; } r -= I_A;
        if (r < I_A) { p0_transpose_item<false>(F.wb, 512, DM, F.WB, scr, r, F.lane); continue; } r -= I_A;
        p0_transpose_item<false>(F.wo, DM, DM, F.WOUT, scr, r, F.lane);
    }
    DIL_END(60);
    DIL_BEGIN(61);
    {
        f32x4 gv[4];
#pragma unroll
        for (int j = 0; j < 4; ++j) gv[j] = ((const f32x4*)F.g1)[F.lane + 64 * j];
        for (int m = 2 * gw; m < T; m += 2 * NGW) {
            const f32x4* xr0 = (const f32x4*)(F.x + (size_t)m * DM) + F.lane; const f32x4* xr1 = (const f32x4*)(F.x + (size_t)(m + 1) * DM) + F.lane;
            f32x4 v0[4], v1[4]; float s0 = 0.f, s1 = 0.f;
#pragma unroll
            for (int j = 0; j < 4; ++j) { v0[j] = __builtin_nontemporal_load(xr0 + 64 * j); v1[j] = __builtin_nontemporal_load(xr1 + 64 * j); }
#pragma unroll
            for (int j = 0; j < 4; ++j) { s0 += (v0[j].x * v0[j].x + v0[j].y * v0[j].y) + (v0[j].z * v0[j].z + v0[j].w * v0[j].w); s1 += (v1[j].x * v1[j].x + v1[j].y * v1[j].y) + (v1[j].z * v1[j].z + v1[j].w * v1[j].w); }
            const float rs0 = 1.0f / sqrtf(wave_sum(s0) * (1.0f / DM) + EPS), rs1 = 1.0f / sqrtf(wave_sum(s1) * (1.0f / DM) + EPS);
            u32x2* o0 = (u32x2*)(F.XN + (size_t)m * DM) + F.lane; u32x2* o1 = (u32x2*)(F.XN + (size_t)(m + 1) * DM) + F.lane;
#pragma unroll
            for (int j = 0; j < 4; ++j) { const f32x4 y0 = v0[j] * rs0 * gv[j], y1 = v1[j] * rs1 * gv[j]; u32x2 w0, w1; w0.x = pk1(y0.x, y0.y); w0.y = pk1(y0.z, y0.w); w1.x = pk1(y1.x, y1.y); w1.y = pk1(y1.z, y1.w); o0[64 * j] = w0; o1[64 * j] = w1; }
        }
    }
    DIL_END(61);
    DIL_BEGIN(62);
    const int gt = F.vcu * (NWAVES * 64) + F.tid, NGT = F.G * NWAVES * 64;
    for (int idx = gt; idx < SEQ * 12; idx += NGT) {
        const int pos = idx / 12, e = idx % 12; const int half = e < 8 ? 8 : 4, i = e < 8 ? e : e - 8;
        const float inv = powf(500000.0f, -(float)i / (float)half);
        const float ang = (float)pos * inv; float c, s; sincos_acc(ang, c, s);
        float* dst = e < 8 ? (F.ROPEB + (size_t)pos * 16 + 2 * i) : (F.ROPEI + (size_t)pos * 8 + 2 * i);
        dst[0] = c; dst[1] = s;
    }
    for (int idx = gt; idx < 8 * 513; idx += NGT) F.BIAS[idx] = F.relb[idx] * LOG2E;
    DIL_END(62);
}

__device__ __forceinline__ float half_swap_max(float v) { auto rr = __builtin_amdgcn_permlane32_swap(__float_as_uint(v), __float_as_uint(v), false, false); return fmaxf(__uint_as_float(rr[0]), __uint_as_float(rr[1])); }
__device__ __forceinline__ float half_swap_sum(float v) { auto rr = __builtin_amdgcn_permlane32_swap(__float_as_uint(v), __float_as_uint(v), false, false); return __uint_as_float(rr[0]) + __uint_as_float(rr[1]); }
__device__ __forceinline__ void attn_a_unit(const Frame& F, int b, int h, int c, const LAS float* biasL) {
    const int lane = F.lane, r = lane & 31, hh = lane >> 5;
    const size_t tokbase = (size_t)b * SEQ; const int t0 = c * 64;
    h16x8 qf[2][4];
#pragma unroll
    for (int qb = 0; qb < 2; ++qb)
#pragma unroll
        for (int s = 0; s < 4; ++s) qf[qb][s] = *(const h16x8*)(F.QA + (((((size_t)(b * 8 + h) * 64 + c) * 2 + qb) * 4 + s) * 64 + lane) * 8);
    f32x16 o[2][2];
#pragma unroll
    for (int a = 0; a < 2; ++a)
#pragma unroll
        for (int q = 0; q < 2; ++q)
#pragma unroll
            for (int e = 0; e < 16; ++e) o[a][q][e] = 0.f;
    float mrun[2] = {0.f, 0.f}, lrun[2] = {0.f, 0.f};
    const h16* Kb = F.KA + ((size_t)(b * 8 + h) * 128 * 8 * 32 + lane) * 8;
    const h16* Vb = F.VAT + (((size_t)(b * 8 + h) * 512 + hh) * 64 + r) * 8;
    const LAS float* bh = biasL + h * 448;
    const float bfar = bh[0];
    const int kc0 = c > 8 ? c - 8 : 0;
    const int nit = 2 * (c - kc0 + 1), sbase = kc0 * 64;
    h16x8 kf[4], vf[2][2], kn[4], vn[2][2];
#pragma unroll
    for (int s = 0; s < 4; ++s) kf[s] = *(const h16x8*)(Kb + (size_t)((sbase >> 5) * 4 + s) * 512);
#pragma unroll
    for (int dt = 0; dt < 2; ++dt)
#pragma unroll
        for (int sp = 0; sp < 2; ++sp) vf[dt][sp] = *(const h16x8*)(Vb + (size_t)(((sbase >> 3) + 2 * sp) * 64 + 32 * dt) * 8);
    {
        auto half_tile = [&](auto last_tag, const h16x8 (&kf)[4], const h16x8 (&vf)[2][2], h16x8 (&kn)[4], h16x8 (&vn)[2][2], const int it) {
            constexpr bool LAST = decltype(last_tag)::value;
            const int s0 = sbase + 32 * it;
            if (LAST) {
                const h16* g0 = F.GA + ((((size_t)(b * 8 + h) * 64 + c) * 2) * 4 * 64 + lane) * 8;
#pragma unroll
                for (int s = 0; s < 4; ++s) kn[s] = *(const h16x8*)(g0 + (size_t)s * 512);
#pragma unroll
                for (int dt = 0; dt < 2; ++dt)
#pragma unroll
                    for (int sp = 0; sp < 2; ++sp) vn[dt][sp] = *(const h16x8*)(g0 + (size_t)(4 + 2 * dt + sp) * 512);
            } else {
                const int s1 = s0 + 32;
#pragma unroll
                for (int s = 0; s < 4; ++s) kn[s] = *(const h16x8*)(Kb + (size_t)((s1 >> 5) * 4 + s) * 512);
#pragma unroll
                for (int dt = 0; dt < 2; ++dt)
#pragma unroll
                    for (int sp = 0; sp < 2; ++sp) vn[dt][sp] = *(const h16x8*)(Vb + (size_t)(((s1 >> 3) + 2 * sp) * 64 + 32 * dt) * 8);
            }
            const int delta = t0 - s0;
#pragma unroll
            for (int qb = 0; qb < 2; ++qb) {
                auto scores = [&]() -> f32x16 {
                    f32x16 S;
                    const float nm = -mrun[qb];
                    if (delta + 32 * qb >= 288) {
                        const float c0 = bfar + nm;
#pragma unroll
                        for (int e = 0; e < 16; ++e) S[e] = c0;
                    } else {
                        const LAS float* bp = bh + (320 - (delta + 32 * qb + r - 8 * hh));
#pragma unroll
                        for (int e = 0; e < 16; ++e) { const int kr = (e & 3) + 4 * ((e >> 2) & 1) + 16 * (e >> 3); S[e] = bp[kr] + nm; }
                    }
#pragma unroll
                    for (int s = 0; s < 4; ++s) S = __builtin_amdgcn_mfma_f32_32x32x16_f16(kf[s], qf[qb][s], S, 0, 0, 0);
                    return S;
                };
                f32x16 S = scores();
                float ps = 0.f;
                if (it != 0) {
#pragma unroll
                    for (int e = 0; e < 16; ++e) { S[e] = fexp2(S[e]); ps += S[e]; }
                }
                if (it == 0 || __any(!(ps <= 4096.0f))) {
                    if (it != 0) S = scores();
                    float tm = S[0];
#pragma unroll
                    for (int e = 1; e < 16; ++e) tm = fmaxf(tm, S[e]);
                    tm = half_swap_max(tm);
                    const float dl = it == 0 ? tm : fmaxf(tm, 0.f), alpha = fexp2(-dl);
                    mrun[qb] += dl; lrun[qb] *= alpha;
#pragma unroll
                    for (int dt = 0; dt < 2; ++dt)
#pragma unroll
                        for (int e = 0; e < 16; ++e) o[dt][qb][e] *= alpha;
                    ps = 0.f;
#pragma unroll
                    for (int e = 0; e < 16; ++e) { S[e] = fexp2(S[e] - dl); ps += S[e]; }
                }
                lrun[qb] += ps;
                u32x4 pw[2];
#pragma unroll
                for (int sp = 0; sp < 2; ++sp) { pw[sp].x = pkh(S[8 * sp + 0], S[8 * sp + 1]); pw[sp].y = pkh(S[8 * sp + 2], S[8 * sp + 3]); pw[sp].z = pkh(S[8 * sp + 4], S[8 * sp + 5]); pw[sp].w = pkh(S[8 * sp + 6], S[8 * sp + 7]); }
#pragma unroll
                for (int dt = 0; dt < 2; ++dt)
#pragma unroll
                    for (int sp = 0; sp < 2; ++sp) o[dt][qb] = __builtin_amdgcn_mfma_f32_32x32x16_f16(vf[dt][sp], __builtin_bit_cast(h16x8, pw[sp]), o[dt][qb], 0, 0, 0);
            }
        };
#pragma unroll 1
        for (int it = 0; it < nit - 2; it += 2) {
            half_tile(std::false_type{}, kf, vf, kn, vn, it);
            half_tile(std::false_type{}, kn, vn, kf, vf, it + 1);
        }
        half_tile(std::false_type{}, kf, vf, kn, vn, nit - 2);
        half_tile(std::true_type{}, kn, vn, kf, vf, nit - 1);
    }
#pragma unroll
    for (int qb = 0; qb < 2; ++qb) {
        const float inv = 1.0f / half_swap_sum(lrun[qb]);
        const size_t rowoff = (tokbase + t0 + 32 * qb + r) * 512 + h * 64 + 8 * hh;
        h16x8 gv[4];
#pragma unroll
        for (int p = 0; p < 4; ++p) gv[p] = qb == 0 ? kf[p] : vf[p >> 1][p & 1];
#pragma unroll
        for (int p = 0; p < 4; ++p) {
            const int dt = p >> 1, ga_ = 4 * (2 * (p & 1)), gb_ = ga_ + 4;
            u32x2 a, b;
            a.x = pkh(o[dt][qb][ga_ + 0] * inv, o[dt][qb][ga_ + 1] * inv); a.y = pkh(o[dt][qb][ga_ + 2] * inv, o[dt][qb][ga_ + 3] * inv);
            b.x = pkh(o[dt][qb][gb_ + 0] * inv, o[dt][qb][gb_ + 1] * inv); b.y = pkh(o[dt][qb][gb_ + 2] * inv, o[dt][qb][gb_ + 3] * inv);
            { auto rr = __builtin_amdgcn_permlane32_swap(a.x, b.x, false, false); a.x = rr[0]; b.x = rr[1]; }
            { auto rr = __builtin_amdgcn_permlane32_swap(a.y, b.y, false, false); a.y = rr[0]; b.y = rr[1]; }
            const u32x4 packed = {a.x, a.y, b.x, b.y};
            const h16x8 res = __builtin_bit_cast(h16x8, packed) * gv[p];
            *(u32x4*)(F.YA + rowoff + 16 * p) = __builtin_bit_cast(u32x4, res);
        }
    }
}

__device__ __forceinline__ unsigned fkey(float f) { const unsigned u = __float_as_uint(f); return (u & 0x80000000u) ? ~u : (u | 0x80000000u); }
__device__ __forceinline__ unsigned mbcnt64(unsigned long long m) { return __builtin_amdgcn_mbcnt_hi((unsigned)(m >> 32), __builtin_amdgcn_mbcnt_lo((unsigned)m, 0u)); }
#define SUBREP(k) ((REP_PHASE) == (k) ? 2 : 1)
__device__ __forceinline__ float unkey(unsigned k) { return __uint_as_float((k & 0x80000000u) ? (k & 0x7fffffffu) : ~k); }
__device__ __forceinline__ float dpp_ror8(float v) { return __uint_as_float((unsigned)__builtin_amdgcn_update_dpp((int)__float_as_uint(v), (int)__float_as_uint(v), 0x128, 0xf, 0xf, true)); }
__device__ __forceinline__ unsigned scan_incl_u(unsigned v) {
    v += (unsigned)__builtin_amdgcn_update_dpp(0, (int)v, 0x111, 0xf, 0xf, false);
    v += (unsigned)__builtin_amdgcn_update_dpp(0, (int)v, 0x112, 0xf, 0xf, false);
    v += (unsigned)__builtin_amdgcn_update_dpp(0, (int)v, 0x114, 0xf, 0xf, false);
    v += (unsigned)__builtin_amdgcn_update_dpp(0, (int)v, 0x118, 0xf, 0xf, false);
    v += (unsigned)__builtin_amdgcn_update_dpp(0, (int)v, 0x142, 0xa, 0xf, false);
    v += (unsigned)__builtin_amdgcn_update_dpp(0, (int)v, 0x143, 0xc, 0xf, false);
    return v;
}
__device__ __forceinline__ int exscan_u(unsigned v, int lane, unsigned& total) {
    const unsigned inc = scan_incl_u(v);
    total = (unsigned)__builtin_amdgcn_readlane((int)inc, 63);
    return (int)(inc - v);
}
__device__ __forceinline__ float x16_max(float v) { auto rr = __builtin_amdgcn_permlane16_swap(__float_as_uint(v), __float_as_uint(v), false, false); return fmaxf(__uint_as_float(rr[0]), __uint_as_float(rr[1])); }
__device__ __forceinline__ float x16_sum(float v) { auto rr = __builtin_amdgcn_permlane16_swap(__float_as_uint(v), __float_as_uint(v), false, false); return __uint_as_float(rr[0]) + __uint_as_float(rr[1]); }
__device__ __forceinline__ void dsa_unit(const Frame& F, int b, int qg, int par, bool havepre, int nqg, int pub, int& got) {
    const int lane = F.lane, wave = F.wave;
    const size_t tokbase = (size_t)b * SEQ; const int t0 = qg * 8, c = t0 >> 6, n = (c + 1) * 64;
    LAS float* scores = (LAS float*)F.lds;
    LAS float* row = scores + wave * 4096;
    LAS unsigned* hist = (LAS unsigned*)(F.lds + LDS_HIST) + wave * 512;
    LAS unsigned short* idxl = (LAS unsigned short*)(F.lds + LDS_IDX) + wave * 256;
    LAS unsigned* mm = (LAS unsigned*)(F.lds + LDS_MM) + 16 * par;
    DIL_BEGIN(10);
    if (n > 256) {
        for (int rp = 0; rp < SUBREP(7); ++rp) {
            DIL_BEGIN(15);
            const int q = lane & 7, hs = (lane >> 3) & 1, g = lane >> 4;
            h16x8 bq[4]; float w[4];
#pragma unroll
            for (int hp = 0; hp < 4; ++hp) {
                if (havepre) { bq[hp] = *(const LAS h16x8*)(F.lds + LDS_PRE + q * 528 + (2 * hp + hs) * 64 + 16 * g); w[hp] = 0.5f * ((const LAS float*)(F.lds + LDS_PRE + 8 * 528))[q * 8 + 2 * hp + hs]; }
                else { bq[hp] = *(const h16x8*)(F.IQ + (tokbase + t0 + q) * 256 + (2 * hp + hs) * 32 + 8 * g); w[hp] = 0.5f * F.IW[(tokbase + t0 + q) * 8 + 2 * hp + hs]; }
            }
            h16x8 blin;
            {
                float bl[8];
#pragma unroll
                for (int j = 0; j < 8; ++j) { bl[j] = 0.f;
#pragma unroll
                    for (int hp = 0; hp < 4; ++hp) bl[j] += w[hp] * (float)bq[hp][j]; }
#pragma unroll
                for (int j = 0; j < 8; ++j) { bl[j] += dpp_ror8(bl[j]); const h16 hi = (h16)bl[j]; const h16 lo = (h16)(bl[j] - (float)hi); blin[j] = hs == 0 ? hi : lo; }
            }
            DIL_END(15);
            DIL_BEGIN(16);
            LAS float* sp = scores + q * 4096 + 4 * (g ^ (q & 3)) + 16 * (wave + ((q >> 2) ? ((wave & 1) ? -1 : 1) : 0));
            const int ntile = n >> 4;
            const h16* ikp = F.IK + (tokbase / 16) * 512 + (size_t)lane * 8;
            float lmn = 3.0e38f, lmx = -3.0e38f;
            h16x8 ak[4], an[4];
            const int nmy = (ntile - wave + 7) >> 3;
#pragma unroll
            for (int u = 0; u < 4; ++u) { const int j = u < nmy ? u : nmy - 1; ak[u] = *(const h16x8*)(ikp + (size_t)(wave + 8 * j) * 512); }
            auto group4 = [&](auto full_tag, const h16x8 (&ak)[4], h16x8 (&an)[4], const int j0) {
                constexpr bool FULL = decltype(full_tag)::value;
#pragma unroll
                for (int u = 0; u < 4; ++u) { const int jj = j0 + 4 + u, j = (FULL || jj < nmy) ? jj : nmy - 1; an[u] = *(const h16x8*)(ikp + (size_t)(wave + 8 * j) * 512); }
#pragma unroll
                for (int u = 0; u < 4; ++u) {
                    if (FULL || j0 + u < nmy) {
                        f32x4 acc = {0.f, 0.f, 0.f, 0.f};
                        acc = __builtin_amdgcn_mfma_f32_16x16x32_f16(ak[u], blin, acc, 0, 0, 0);
#pragma unroll
                        for (int hp = 0; hp < 4; ++hp) {
                            f32x4 cz = {0.f, 0.f, 0.f, 0.f};
                            cz = __builtin_amdgcn_mfma_f32_16x16x32_f16(ak[u], bq[hp], cz, 0, 0, 0);
#pragma unroll
                            for (int e = 0; e < 4; ++e) { acc[e] = __builtin_fmaf(__builtin_fabsf(cz[e]), w[hp], acc[e]); asm volatile("" : "+v"(acc[e])); }
                        }
#pragma unroll
                        for (int e = 0; e < 4; ++e) { acc[e] += dpp_ror8(acc[e]); asm volatile("" : "+v"(acc[e])); }
#pragma unroll
                        for (int e = 0; e < 4; ++e) { lmn = fminf(lmn, acc[e]); lmx = fmaxf(lmx, acc[e]); }
                        *(LAS f32x4*)(sp + 128 * (j0 + u)) = acc;
                    }
                }
            };
            {
                int j0 = 0;
                for (; j0 + 8 <= nmy; j0 += 8) { group4(std::true_type{}, ak, an, j0); group4(std::true_type{}, an, ak, j0 + 4); }
                if (j0 < nmy) { group4(std::false_type{}, ak, an, j0); if (j0 + 4 < nmy) group4(std::false_type{}, an, ak, j0 + 4); }
            }
            DIL_END(16);
            lmn = -half_swap_max(x16_max(-lmn)); lmx = half_swap_max(x16_max(lmx));
            if (lane < 8 && lmx >= lmn) { __hip_atomic_fetch_min(mm + lane, fkey(lmn), __ATOMIC_RELAXED, __HIP_MEMORY_SCOPE_WORKGROUP); __hip_atomic_fetch_max(mm + 8 + lane, fkey(lmx), __ATOMIC_RELAXED, __HIP_MEMORY_SCOPE_WORKGROUP); }
        }
    }
    DIL_END(10);
    DIL_BEGIN(13);
    __syncthreads();
    DIL_END(13);
    DIL_BEGIN(11);
    if (F.tid < 16) ((LAS unsigned*)(F.lds + LDS_MM))[16 * (par ^ 1) + F.tid] = F.tid < 8 ? 0xffffffffu : 0u;
    u32x4 st[16]; bool early = false;
    if (n > 256) for (int rp = 0; rp < SUBREP(8); ++rp) {
        DIL_BEGIN(20);
        const int ngrp = (n + 255) >> 8;
        const int nch = (4 * lane < n) ? ((n - 4 * lane + 255) >> 8) : 0;
        const unsigned long long validm = nch >= 16 ? ~0ull : ((1ull << (4 * nch)) - 1ull);
        f32x4 v4[16];
#pragma unroll
        for (int j = 0; j < 16; ++j) if (j < ngrp) v4[j] = *(const LAS f32x4*)(row + 4 * ((64 * j + lane) ^ wave));
        const float mn = unkey(mm[wave]), mx = unkey(mm[8 + wave]);
        const float range = mx - mn;
        const unsigned Rbits = ((__float_as_uint(range) >> 23) + 1u) << 23;
        const float cadd = __uint_as_float(Rbits) - mn;
        ((LAS u32x4*)hist)[lane * 2] = (u32x4){0u, 0u, 0u, 0u}; ((LAS u32x4*)hist)[lane * 2 + 1] = (u32x4){0u, 0u, 0u, 0u};
        asm volatile("s_waitcnt lgkmcnt(0)" ::: "memory");
        DIL_END(20);
        DIL_BEGIN(21);
#pragma unroll
        for (int j = 0; j < 16; ++j) if (j < ngrp) {
            if (j < nch) {
#pragma unroll
                for (int e = 0; e < 4; ++e) { const float u = v4[j][e] + cadd; int bi = ((int)(__float_as_uint(u) - Rbits)) >> 14; bi = bi < 0 ? 0 : (bi > 511 ? 511 : bi);
                    __hip_atomic_fetch_add(hist + bi, 1u, __ATOMIC_RELAXED, __HIP_MEMORY_SCOPE_WORKGROUP); }
            }
        }
        asm volatile("s_waitcnt lgkmcnt(0)" ::: "memory");
        DIL_END(21);
        DIL_BEGIN(22);
        int bstar; unsigned above;
        {
            const u32x4 h0 = ((LAS u32x4*)hist)[lane * 2], h1 = ((LAS u32x4*)hist)[lane * 2 + 1];
            const unsigned hb[8] = {h0.x, h0.y, h0.z, h0.w, h1.x, h1.y, h1.z, h1.w};
            const unsigned s = (h0.x + h0.y) + (h0.z + h0.w) + (h1.x + h1.y) + (h1.z + h1.w);
            const unsigned inc_ = scan_incl_u(s); const unsigned tot_ = (unsigned)__builtin_amdgcn_readlane((int)inc_, 63);
            const unsigned Tl = tot_ - inc_ + s;
            const unsigned long long bal = __ballot(Tl >= 256u);
            const int L = __popcll(bal) - 1;
            unsigned cab = Tl - s; int bst = 0; unsigned ab = 0; bool found = false;
#pragma unroll
            for (int j = 7; j >= 0; --j) { if (!found) { if (cab + hb[j] >= 256u) { bst = 8 * lane + j; ab = cab; found = true; } else cab += hb[j]; } }
            bstar = __builtin_amdgcn_readlane(bst, L); above = (unsigned)__builtin_amdgcn_readlane((int)ab, L);
        }
        DIL_END(22);
        DIL_BEGIN(23);
        const unsigned need = 256u - above;
        const unsigned UhiB = bstar < 511 ? Rbits + ((unsigned)(bstar + 1) << 14) : 0x7f800000u;
        const unsigned UloB = bstar > 0 ? Rbits + ((unsigned)bstar << 14) : 0u;
        unsigned nh[2] = {0u, 0u}, nl[2] = {0u, 0u};
#pragma unroll
        for (int j = 0; j < 16; ++j) {
            if (j < ngrp) {
#pragma unroll
                for (int e = 0; e < 4; ++e) { const unsigned ub = __float_as_uint(v4[j][e] + cadd);
                    nh[j >> 3] = __builtin_amdgcn_alignbit(nh[j >> 3], ub - UhiB, 31); nl[j >> 3] = __builtin_amdgcn_alignbit(nl[j >> 3], ub - UloB, 31); }
            } else { nh[j >> 3] = (nh[j >> 3] << 4) | 15u; nl[j >> 3] = (nl[j >> 3] << 4) | 15u; }
        }
        unsigned long long selm, canm;
        { const unsigned ge_hi0 = __builtin_bitreverse32(~nh[0]), ge_hi1 = __builtin_bitreverse32(~nh[1]), ge_lo0 = __builtin_bitreverse32(~nl[0]), ge_lo1 = __builtin_bitreverse32(~nl[1]);
          selm = ((((unsigned long long)ge_hi1) << 32) | ge_hi0) & validm; canm = ((((unsigned long long)(ge_lo1 & ~ge_hi1)) << 32) | (ge_lo0 & ~ge_hi0)) & validm; }
        const unsigned m = (unsigned)__builtin_amdgcn_readlane((int)scan_incl_u((unsigned)__popcll(canm)), 63);
        DIL_END(23);
        DIL_BEGIN(24);
        if (m > 256u) {
            DIL_BEGIN(27);
            const int nslot = n >> 6;
#define ROWAT(i) row[4 * ((16 * (i) + (lane >> 2)) ^ wave) + (lane & 3)]
            unsigned cur = 0;
#pragma unroll 1
            for (int bit = 31; bit >= 0; --bit) { const unsigned trial = cur | (1u << bit); unsigned cnt = 0;
#pragma unroll 1
                for (int i = 0; i < nslot; ++i) cnt += fkey(ROWAT(i)) >= trial ? 1u : 0u;
                cnt = wave_sum_u(cnt); if (cnt >= 256u) cur = trial; }
            unsigned cgt = 0;
#pragma unroll 1
            for (int i = 0; i < nslot; ++i) cgt += fkey(ROWAT(i)) > cur ? 1u : 0u;
            cgt = wave_sum_u(cgt);
            const unsigned needt = 256u - cgt; unsigned bs = 0, seen = 0;
#pragma unroll 1
            for (int i = 0; i < nslot; ++i) { const unsigned k = fkey(ROWAT(i)); const bool eq = k == cur;
                const unsigned long long me = __ballot(eq); const bool take = k > cur || (eq && seen + mbcnt64(me) < needt);
                const unsigned long long mt = __ballot(take);
                if (take) idxl[bs + mbcnt64(mt)] = (unsigned short)(i * 64 + lane);
                bs += (unsigned)__popcll(mt); seen += (unsigned)__popcll(me); }
#undef ROWAT
            DIL_END(27);
        } else {
            {
                DIL_BEGIN(25);
                unsigned tot; int off = exscan_u((unsigned)__popcll(selm), lane, tot);
                while (selm) { const int bit = __builtin_ctzll(selm); selm &= selm - 1ull; idxl[off++] = (unsigned short)(256 * (bit >> 2) + 4 * lane + (bit & 3)); }
                DIL_END(25);
            }
            if (above >= 64u) {
                early = true;
                const h16* kvb0 = F.KVB + tokbase * 128 + 8 * (lane & 15);
#pragma unroll
                for (int i = 0; i < 16; ++i) { const int kidx = idxl[4 * i + (lane >> 4)]; st[i] = *(const u32x4*)(kvb0 + (size_t)kidx * 128); }
            }
            if (m) {
                DIL_BEGIN(26);
                LAS float* candv = (LAS float*)hist; LAS unsigned short* candi = (LAS unsigned short*)(hist + 256);
                unsigned tot; int off = exscan_u((unsigned)__popcll(canm), lane, tot);
                while (canm) { const int bit = __builtin_ctzll(canm); canm &= canm - 1ull;
                    candv[off] = row[4 * ((64 * (bit >> 2) + lane) ^ wave) + (bit & 3)]; candi[off] = (unsigned short)(256 * (bit >> 2) + 4 * lane + (bit & 3)); ++off; }
                asm volatile("s_waitcnt lgkmcnt(0)" ::: "memory");
                if (m <= 64u) {
                    const bool ok = (unsigned)lane < m; const float cv = ok ? candv[ok ? lane : 0] : 0.f; const unsigned ci = ok ? candi[ok ? lane : 0] : 0u; unsigned rank = 0u;
                    for (unsigned k = 0; k < m; ++k) { const float vk = __uint_as_float((unsigned)__builtin_amdgcn_readlane((int)__float_as_uint(cv), (int)k)); const unsigned ik2 = (unsigned)__builtin_amdgcn_readlane((int)ci, (int)k);
                        rank += (vk > cv || (vk == cv && ik2 < ci)) ? 1u : 0u; }
                    const bool win = ok && rank < need;
                    const unsigned long long mw = __ballot(win);
                    if (win) idxl[above + mbcnt64(mw)] = (unsigned short)ci;
                } else {
                    float cv[4]; unsigned ci[4], rank[4];
#pragma unroll
                    for (int r = 0; r < 4; ++r) { const unsigned j = (unsigned)lane + 64u * r; const bool ok = j < m; cv[r] = ok ? candv[ok ? j : 0] : 0.f; ci[r] = ok ? candi[ok ? j : 0] : 0u; rank[r] = 0u; }
                    const int nr = (int)((m + 63u) >> 6);
#pragma unroll 4
                    for (unsigned k = 0; k < m; ++k) { const float vk = candv[k]; const unsigned ik2 = candi[k];
#pragma unroll
                        for (int r = 0; r < 4; ++r) rank[r] += (vk > cv[r] || (vk == cv[r] && ik2 < ci[r])) ? 1u : 0u; }
                    unsigned wbase = above;
#pragma unroll
                    for (int r = 0; r < 4; ++r) if (r < nr) {
                        const bool win = ((unsigned)lane + 64u * r) < m && rank[r] < need;
                        const unsigned long long mw = __ballot(win);
                        if (win) idxl[wbase + mbcnt64(mw)] = (unsigned short)ci[r];
                        wbase += (unsigned)__popcll(mw);
                    }
                }
                DIL_END(26);
            }
        }
        DIL_END(24);
    } else {
#pragma unroll
        for (int i = 0; i < 4; ++i) idxl[i * 64 + lane] = (unsigned short)((i * 64 + lane) < n ? (i * 64 + lane) : 0);
    }
    const int nsel = n > 256 ? 256 : n;
    asm volatile("s_waitcnt lgkmcnt(0)" ::: "memory");
    DIL_END(11);
    if (nqg >= 0) {
        const size_t ntok = tokbase + (size_t)nqg * 8;
        if (lane < 32) __builtin_amdgcn_global_load_lds((const unsigned*)(F.IQ + (ntok + wave) * 256 + lane * 8), (LAS unsigned*)(F.lds + LDS_PRE + wave * 528), 16, 0, 0);
        if (wave == 0 && lane < 16) __builtin_amdgcn_global_load_lds((const unsigned*)(F.IW + ntok * 8 + lane * 4), (LAS unsigned*)(F.lds + LDS_PRE + 8 * 528), 16, 0, 0);
    }
    DIL_BEGIN(12);
    for (int rp = 0; rp < SUBREP(9); ++rp) {
        DIL_BEGIN(30);
        const int col = lane & 15, g = lane >> 4; const size_t tok = tokbase + t0 + wave;
        h16x8 qf[2];
#pragma unroll
        for (int s = 0; s < 2; ++s) { if (col < 8) qf[s] = *(const h16x8*)(F.QB + tok * 512 + col * 64 + 32 * s + 8 * g); else { qf[s] = (h16x8){0, 0, 0, 0, 0, 0, 0, 0}; } }
        const int ntile = nsel >> 4;
        const h16* kvb = F.KVB + tokbase * 128 + 8 * (lane & 15);
        const int eoff = (g & 1) ? 16 + 4 * (g - 1) : 4 * g;
        h16x8 gbv[2];
#pragma unroll
        for (int p = 0; p < 2; ++p) gbv[p] = *(const h16x8*)(F.GB + tok * 512 + (col & 7) * 64 + 32 * p + eoff);
        u32x4 sn[16];
        if (!early) {
#pragma unroll
            for (int i = 0; i < 16; ++i) { const int kidx = idxl[4 * i + (lane >> 4)]; st[i] = *(const u32x4*)(kvb + (size_t)kidx * 128); }
        }
        LAS unsigned char* vst = (LAS unsigned char*)row;
#define SWZ(rr) ((((rr) & 7) << 1) | (((rr) >> 3) & 1))
        f32x4 O[4];
#pragma unroll
        for (int dt = 0; dt < 4; ++dt) O[dt] = (f32x4){0.f, 0.f, 0.f, 0.f};
        float mrun = -1.0e30f, lrun = 0.f;
#pragma unroll
        for (int pc = 0; pc < 4; ++pc) {
#pragma unroll
            for (int i = 0; i < 16; ++i) { const int rr = 4 * i + (lane >> 4); *(LAS u32x4*)(vst + rr * 256 + 16 * ((lane & 15) ^ SWZ(rr))) = st[i]; }
            if (pc + 1 < 4) {
#pragma unroll
                for (int i = 0; i < 16; ++i) { const int kidx = idxl[64 * (pc + 1) + 4 * i + (lane >> 4)]; sn[i] = *(const u32x4*)(kvb + (size_t)kidx * 128); }
            }
            asm volatile("s_waitcnt lgkmcnt(0)" ::: "memory");
            f32x4 S4[4];
#pragma unroll
            for (int tt = 0; tt < 4; ++tt) {
                const int rr = 16 * tt + col;
                const h16x8 a0 = *(const LAS h16x8*)(vst + rr * 256 + 16 * (g ^ SWZ(rr))), a1 = *(const LAS h16x8*)(vst + rr * 256 + 16 * ((4 + g) ^ SWZ(rr)));
                S4[tt] = (f32x4){0.f, 0.f, 0.f, 0.f};
                S4[tt] = __builtin_amdgcn_mfma_f32_16x16x32_f16(a0, qf[0], S4[tt], 0, 0, 0); S4[tt] = __builtin_amdgcn_mfma_f32_16x16x32_f16(a1, qf[1], S4[tt], 0, 0, 0);
            }
            float tm = -3.0e38f;
#pragma unroll
            for (int tt = 0; tt < 4; ++tt) { if (4 * pc + tt >= ntile) S4[tt] = (f32x4){-3.0e38f, -3.0e38f, -3.0e38f, -3.0e38f}; tm = fmaxf(fmaxf(tm, fmaxf(S4[tt][0], S4[tt][1])), fmaxf(S4[tt][2], S4[tt][3])); }
            tm = half_swap_max(x16_max(tm));
            if (__any(tm > mrun + 8.0f)) {
                const float mnew = fmaxf(mrun, tm), alpha = fexp2(mrun - mnew);
                mrun = mnew; lrun *= alpha;
#pragma unroll
                for (int dt = 0; dt < 4; ++dt) O[dt] = O[dt] * alpha;
            }
#pragma unroll
            for (int tt = 0; tt < 4; ++tt)
#pragma unroll
                for (int e = 0; e < 4; ++e) { S4[tt][e] = fexp2(S4[tt][e] - mrun); lrun += S4[tt][e]; }
#pragma unroll
            for (int kh = 0; kh < 2; ++kh) {
                u32x4 pw; pw.x = pkh(S4[2 * kh][0], S4[2 * kh][1]); pw.y = pkh(S4[2 * kh][2], S4[2 * kh][3]); pw.z = pkh(S4[2 * kh + 1][0], S4[2 * kh + 1][1]); pw.w = pkh(S4[2 * kh + 1][2], S4[2 * kh + 1][3]);
                const h16x8 pb = __builtin_bit_cast(h16x8, pw);
                const int i16 = lane & 15, qq = i16 >> 2, pp = i16 & 3;
                const int r0 = 32 * kh + 4 * g + qq, r1 = r0 + 16;
#pragma unroll
                for (int dt = 0; dt < 4; ++dt) {
                    const int ch = 8 + 2 * dt + (pp >> 1);
                    const s16x4 lo = __builtin_amdgcn_ds_read_tr16_b64_v4i16((LAS s16x4*)(vst + r0 * 256 + 16 * (ch ^ SWZ(r0)) + 8 * (pp & 1)));
                    const s16x4 hi = __builtin_amdgcn_ds_read_tr16_b64_v4i16((LAS s16x4*)(vst + r1 * 256 + 16 * (ch ^ SWZ(r1)) + 8 * (pp & 1)));
                    const h16x8 av = __builtin_bit_cast(h16x8, (__attribute__((ext_vector_type(8))) short){lo[0], lo[1], lo[2], lo[3], hi[0], hi[1], hi[2], hi[3]});
                    O[dt] = __builtin_amdgcn_mfma_f32_16x16x32_f16(av, pb, O[dt], 0, 0, 0);
                }
            }
            asm volatile("s_waitcnt lgkmcnt(0)" ::: "memory");
#pragma unroll
            for (int i = 0; i < 16; ++i) st[i] = sn[i];
        }
#undef SWZ
        DIL_END(30);
        lrun = half_swap_sum(x16_sum(lrun));
        const float inv = 1.0f / lrun;
        asm volatile("s_waitcnt vmcnt(0)" ::: "memory");
#pragma unroll
        for (int p = 0; p < 2; ++p) {
            u32x2 a, b2;
            a.x = pkh(O[2 * p][0] * inv, O[2 * p][1] * inv); a.y = pkh(O[2 * p][2] * inv, O[2 * p][3] * inv);
            b2.x = pkh(O[2 * p + 1][0] * inv, O[2 * p + 1][1] * inv); b2.y = pkh(O[2 * p + 1][2] * inv, O[2 * p + 1][3] * inv);
            { auto rr = __builtin_amdgcn_permlane16_swap(a.x, b2.x, false, false); a.x = rr[0]; b2.x = rr[1]; }
            { auto rr = __builtin_amdgcn_permlane16_swap(a.y, b2.y, false, false); a.y = rr[0]; b2.y = rr[1]; }
            const u32x4 packed = {a.x, a.y, b2.x, b2.y};
            const h16x8 res = __builtin_bit_cast(h16x8, packed) * gbv[p];
            if (col < 8) *(u32x4*)(F.YB + tok * 512 + col * 64 + 32 * p + eoff) = __builtin_bit_cast(u32x4, res);
        }
    }
    DIL_END(12);
    DIL_BEGIN(14);
    if (F.tid == 0) ((volatile LAS int*)(F.lds + MISC_OFF))[16] = pub;
    __syncthreads();
    got = ((volatile LAS int*)(F.lds + MISC_OFF))[16];
    DIL_END(14);
}

__device__ __forceinline__ void p2_branch_a(Frame& F) {
    LAS float* biasL = (LAS float*)F.lds;
    for (int i = F.tid; i < 8 * 448; i += NWAVES * 64) { const int hh_ = i / 448, y = i % 448; int di = 320 - y; di = (di > 256 ? 256 : di) + 256; biasL[i] = F.BIAS[hh_ * 513 + di]; }
    __syncthreads();
    for (int wu = F.vcu; wu < NBATCH * 8 * 8; wu += F.G) {
        const int b = wu >> 6, h = (wu >> 3) & 7, cg = wu & 7;
        attn_a_unit(F, b, h, cg * 8 + F.wave, biasL);
    }
    __syncthreads();
}
__device__ __forceinline__ void p2_branch_b(Frame& F) {
    LAS unsigned* mm = (LAS unsigned*)(F.lds + LDS_MM);
    if (F.tid < 32) mm[F.tid] = (F.tid & 15) < 8 ? 0xffffffffu : 0u;
    __syncthreads();
    int par = 0;
    if (F.G % NBATCH == 0) {
        const int per = F.G / NBATCH, b = F.vcu / per, cul = F.vcu % per, NQG = SEQ / 8;
        const int nround = (NQG + per - 1) / per;
        (void)nround;
        bool havepre = false;
        int cur = NQG - 1 - cul, nxt = NQG - 1 - (per + cul);
        while (cur >= 0) {
            int k2 = -1;
            if (F.tid == 0 && nxt >= 0) k2 = NQG - 1 - (2 * per + (int)__hip_atomic_fetch_add(F.dyn + b, 1u, __ATOMIC_RELAXED, __HIP_MEMORY_SCOPE_AGENT));
            int got = -1;
            dsa_unit(F, b, cur, par, havepre, nxt, k2 < 0 ? -1 : k2, got); par ^= 1; havepre = nxt >= 0;
            cur = nxt; nxt = got;
        }
    } else {
        const int NU = T / 8;
        for (int i = 0; i * F.G < NU; ++i) {
            const int cu = (i & 1) ? (F.G - 1 - F.vcu) : F.vcu;
            const int u = i * F.G + cu; if (u >= NU) break;
            int got_; dsa_unit(F, u & 7, u >> 3, par, false, -1, -1, got_); par ^= 1;
        }
    }
}

__device__ __forceinline__ void p3_final(Frame& F, const h16* Y3) {
    const int gw = (int)blockIdx.x * NWAVES + F.wave, NGW = F.G * NWAVES;
    f32x4 gv[4];
#pragma unroll
    for (int j = 0; j < 4; ++j) gv[j] = ((const f32x4*)F.g2)[F.lane + 64 * j];
    for (int m = gw; m < T; m += NGW) {
        const f32x4* xr = (const f32x4*)(F.x + (size_t)m * DM) + F.lane;
        const u32x2* yr = (const u32x2*)(Y3 + (size_t)m * DM) + F.lane;
        f32x4 v[4]; float s = 0.f;
#pragma unroll
        for (int j = 0; j < 4; ++j) { v[j] = __builtin_nontemporal_load(xr + 64 * j); const h16x4 y = __builtin_bit_cast(h16x4, __builtin_nontemporal_load(yr + 64 * j));
            v[j].x += (float)y[0]; v[j].y += (float)y[1]; v[j].z += (float)y[2]; v[j].w += (float)y[3];
            s += (v[j].x * v[j].x + v[j].y * v[j].y) + (v[j].z * v[j].z + v[j].w * v[j].w); }
        const float rs = 1.0f / sqrtf(wave_sum(s) * (1.0f / DM) + EPS);
        f32x4* orow = (f32x4*)(F.out + (size_t)m * DM) + F.lane;
#pragma unroll
        for (int j = 0; j < 4; ++j) __builtin_nontemporal_store(v[j] * rs * gv[j], orow + 64 * j);
    }
}

struct Args { const float* in[9]; float* out; unsigned char* ws; int ph_lo, ph_hi, li, pad; };
struct UVOrder {
    pg8::StaticOrder base; int nb;
    __device__ void init(int G, int c) { base.init(T, DM, G, c); nb = 0; pg8::Unit t; while (base.next(nb, t)) ++nb; }
    __device__ bool next(int i, pg8::Unit& u) const {
        if (i >= 2 * nb) return false;
        base.next(i >> 1, u);
        if (i & 1) { u.pm += T / 256; u.pn += 4; }
        return true;
    }
    __device__ __forceinline__ void a_ready(const pg8::Unit&) const {}
    __device__ __forceinline__ void done(const pg8::Unit&) const {}
};
struct EpiGateUV {
    static constexpr bool PERM = true, AFTER_DRAIN = false;
    const h16* GTA; const h16* GTB; h16* TMP; h16* MERGED; LAS unsigned char* xb;
    __device__ __forceinline__ void operator()(const f32x4 (&acc_)[2][2][4][2], const pg8::Unit& u, int wr, int wc, int fr, int fq) const {
        f32x4 (&acc)[2][2][4][2] = const_cast<f32x4 (&)[2][2][4][2]>(acc_);
        const bool isv = u.pm >= T / 256; const int pm = isv ? u.pm - T / 256 : u.pm, pn = isv ? u.pn - 4 : u.pn;
        const int lane = fq * 16 + fr, row0 = pm * 256 + wr * 64 + (lane >> 2), col0 = pn * 256 + wc * 32 + 8 * (lane & 3);
        const size_t fo = epi::fragoff(pm, pn, wr, wc, 0, lane);
        u32x4 ga[8], gb[8]; u32x4 pkm = {0u, 0u, 0u, 0u};
#pragma unroll
        for (int hb = 0; hb < 2; ++hb) {
#pragma unroll
            for (int jx = 0; jx < 8; ++jx) gb[jx] = isv ? *(const u32x4*)(GTB + fo + (size_t)(8 * hb + jx) * 512) : epi::ld_nt(GTB + fo + (size_t)(8 * hb + jx) * 512);
            if (!isv) {
#pragma unroll
                for (int jx = 0; jx < 8; ++jx) ga[jx] = epi::ld_nt(GTA + fo + (size_t)(8 * hb + jx) * 512);
            }
#pragma unroll
            for (int jx = 0; jx < 8; ++jx) { const int ix = 8 * hb + jx, ai = ix >> 3, m = (ix >> 1) & 3, bj = ix & 1;
                const h16x8 g2 = __builtin_bit_cast(h16x8, gb[jx]);
                if (!isv) {
                    const h16x8 g1 = __builtin_bit_cast(h16x8, ga[jx]);
#pragma unroll
                    for (int e = 0; e < 4; ++e) { acc[ai][bj][m][0][e] *= (float)g1[e] * frcp(fmaxf((float)g2[e], 6.103515625e-05f)); acc[ai][bj][m][1][e] *= (float)g1[4 + e] * frcp(fmaxf((float)g2[4 + e], 6.103515625e-05f)); }
                } else {
                    f32x4 v0 = acc[ai][bj][m][0], v1 = acc[ai][bj][m][1];
#pragma unroll
                    for (int e = 0; e < 4; ++e) { v0[e] *= fmaxf((float)g2[e], 6.103515625e-05f); v1[e] *= fmaxf((float)g2[4 + e], 6.103515625e-05f); }
                    if (bj == 0) pkm = epi::pack8(v0, v1);
                    else { u32x4 r0, r1; epi::xch_rows2(xb, pkm, epi::pack8(v0, v1), lane, r0, r1); h16* rowp = MERGED + (size_t)(row0 + ai * 128 + m * 16) * 1024 + col0; *(u32x4*)rowp = r0; *(u32x4*)(rowp + 128) = r1; }
                }
            }
        }
    }
};
namespace pg8 { template <> struct pg8_keep<EpiGateUV> { static __device__ __forceinline__ bool f(const Unit& u) { return u.pm < T / 256; } }; }

__global__ void __launch_bounds__(NWAVES * 64, 2) hybrid_fwd(Args args) {
    extern __shared__ __attribute__((aligned(16))) unsigned char lds[];
    Frame F;
    F.lds = (LAS unsigned char*)lds;
    F.tid = threadIdx.x; F.lane = F.tid & 63; F.wave = __builtin_amdgcn_readfirstlane(F.tid >> 6);
    F.G = gridDim.x; { const int bx = blockIdx.x; F.vcu = (F.G % 8 == 0) ? (bx % 8) * (F.G / 8) + bx / 8 : bx; }
    unsigned char* ws = args.ws;
    F.x = args.in[0]; F.g1 = args.in[1]; F.w_in = args.in[2]; F.bm = args.in[3]; F.relb = args.in[4]; F.wa = args.in[5]; F.wb = args.in[6]; F.wo = args.in[7]; F.g2 = args.in[8]; F.out = args.out;
    F.WIN = (h16*)(ws + WS_WIN); F.WA = (h16*)(ws + WS_WA); F.WB = (h16*)(ws + WS_WB); F.WOUT = (h16*)(ws + WS_WOUT);
    F.XN = (h16*)(ws + WS_XN); F.QA = (h16*)(ws + WS_QA); F.KA = (h16*)(ws + WS_KA); F.VAT = (h16*)(ws + WS_VAT); F.GA = (h16*)(ws + WS_GA); F.QB = (h16*)(ws + WS_QB); F.GB = (h16*)(ws + WS_GB);
    F.GTA = (h16*)(ws + WS_GTA); F.GTB = (h16*)(ws + WS_GTB); F.KVB = (h16*)(ws + WS_KVB); F.IQ = (h16*)(ws + WS_IQ); F.IK = (h16*)(ws + WS_IK);
    F.YA = (h16*)(ws + WS_YA); F.YB = (h16*)(ws + WS_YB); F.TMP = (h16*)(ws + WS_TMP); F.MERGED = (h16*)(ws + WS_MERGED); F.Y3 = (h16*)(ws + WS_Y3);
    F.dyn = (unsigned*)(ws + WS_CTL) + CW_BAR + XCD_BAR_WORDS;
    F.IW = (float*)(ws + WS_IW); F.ROPEB = (float*)(ws + WS_ROPEB); F.ROPEI = (float*)(ws + WS_ROPEI); F.BIAS = (float*)(ws + WS_BIAS);
    for (int u = F.tid; u < (LDS_PRE - LDSCTL_OFF) / 4; u += NWAVES * 64) ((LAS unsigned*)(F.lds + LDSCTL_OFF))[u] = 0u;
    __syncthreads();
    volatile LAS unsigned* MISC = (volatile LAS unsigned*)(F.lds + MISC_OFF);
    unsigned* barw = (unsigned*)(ws + WS_CTL) + CW_BAR + args.li * XCD_BAR_WORDS;
    XcdBarrier bar; bar.bar = barw; bar.x = 0; bar.st = nullptr;
    if (N_LAUNCHES != PER_PHASE) bar = xcd_barrier_post(barw, MISC + 8);
#define GRID_BAR() do { if (N_LAUNCHES != PER_PHASE) xcd_barrier(bar); } while (0)
    const int lo = args.ph_lo, hi = args.ph_hi;
#define IN(k) (lo <= (k) && (k) < hi)
#define BOTH(k) (IN(k) && IN((k) + 1))
    typedef const unsigned short* cbp;
    LAS unsigned char* xbw = F.lds + LDS_HIST + F.wave * 2560;
#define NREP(k) ((REP_PHASE) == (k) ? 2 : 1)
    if (IN(0)) for (int rep = 0; rep < NREP(0); ++rep) { DIL_BEGIN(0); p0_prologue(F); DIL_END(0); DIL_BEGIN(40); if (BOTH(0)) GRID_BAR(); DIL_END(40); }
    if (IN(1)) for (int rep = 0; rep < NREP(1); ++rep) {
        DIL_BEGIN(1);
        {
            pg8::Gemm g{(cbp)F.XN, (cbp)F.WIN, T, NMAIN, DM}; pg8::StaticOrder S; S.init(T, NMAIN, F.G, (int)blockIdx.x);
            epi::EpiProj E{F.QA, F.KA, F.GA, F.QB, F.GB, F.GTA, F.GTB, F.KVB, F.IQ, F.IK, F.IW, F.bm, F.ROPEB, F.ROPEI, xbw};
            pg8::gemm_phase<epi::EpiProj, pg8::StaticOrder, true, true, P1_BF16 != 0>(F.lds, g, S, E);
        }
        {
            pg8::Gemm g{(cbp)(F.WIN + (size_t)NMAIN * DM), (cbp)F.XN, 512, T, DM}; pg8::StaticOrder S; S.init(512, T, F.G, (int)blockIdx.x);
            epi::EpiVT E{F.VAT};
            pg8::gemm_phase<epi::EpiVT, pg8::StaticOrder, true, true, P1_BF16 != 0>(F.lds, g, S, E);
        }
        DIL_END(1);
        DIL_BEGIN(41);
        if (BOTH(1)) GRID_BAR();
        DIL_END(41);
    }
    if (IN(2)) {
        DIL_BEGIN(2);
        for (int rep = 0; rep < NREP(2); ++rep) p2_branch_a(F);
        DIL_END(2);
        DIL_BEGIN(3);
        for (int rep = 0; rep < NREP(6); ++rep) p2_branch_b(F);
        DIL_END(3);
        DIL_BEGIN(42);
        if (BOTH(2)) GRID_BAR();
        DIL_END(42);
    }
    if (IN(3)) for (int rep = 0; rep < NREP(3); ++rep) {
        DIL_BEGIN(4);
        {
            pg8::Gemm g{(cbp)F.YA, (cbp)F.WA, 2 * T, 2 * DM, 512}; UVOrder S; S.init(F.G, (int)blockIdx.x);
            EpiGateUV E{F.GTA, F.GTB, F.TMP, F.MERGED, xbw};
            pg8::gemm_phase<EpiGateUV, UVOrder, true, true>(F.lds, g, S, E);
        }
        DIL_END(4);
        DIL_BEGIN(43);
        if (BOTH(3)) GRID_BAR();
        DIL_END(43);
    }
    if (IN(4)) for (int rep = 0; rep < NREP(4); ++rep) {
        DIL_BEGIN(5);
        pg8::Gemm g{(cbp)F.MERGED, (cbp)F.WOUT, T, DM, DM}; pg8::StaticOrder S; S.init(T, DM, F.G, (int)blockIdx.x);
        epi::EpiPlain E{F.Y3, DM, xbw};
        pg8::gemm_phase<epi::EpiPlain, pg8::StaticOrder, true, true>(F.lds, g, S, E);
        DIL_END(5);
        DIL_BEGIN(44);
        if (BOTH(4)) GRID_BAR();
        DIL_END(44);
    }
    if (IN(5)) for (int rep = 0; rep < NREP(5); ++rep) { DIL_BEGIN(6); p3_final(F, F.Y3); DIL_END(6); }
#undef IN
#undef BOTH
#undef NREP
}

extern "C" void kernel_launch(void* const* d_in, const int* in_sizes, int n_in, void* d_out, int out_size, void* d_ws, size_t ws_size, hipStream_t stream) {
    static int grid = 0;
    if (grid == 0) {
        if (n_in != 9 || in_sizes[0] != T * DM || out_size != T * DM || ws_size < WS_END) { fprintf(stderr, "kernel_launch: unexpected shapes / workspace (n_in %d, in0 %d, out %d, ws %zu)\n", n_in, n_in > 0 ? in_sizes[0] : -1, out_size, ws_size); grid = -1; return; }
        int dev = 0, cus = 0, per_cu = 0;
        if (hipGetDevice(&dev) != hipSuccess || hipDeviceGetAttribute(&cus, hipDeviceAttributeMultiprocessorCount, dev) != hipSuccess) { fprintf(stderr, "kernel_launch: device query failed\n"); grid = -1; return; }
        if (hipFuncSetAttribute((const void*)hybrid_fwd, hipFuncAttributeMaxDynamicSharedMemorySize, LDS_BYTES) != hipSuccess) { fprintf(stderr, "kernel_launch: hipFuncSetAttribute failed\n"); grid = -1; return; }
        if (hipOccupancyMaxActiveBlocksPerMultiprocessor(&per_cu, (const void*)hybrid_fwd, NWAVES * 64, LDS_BYTES) != hipSuccess || per_cu < 1)
            fprintf(stderr, "kernel_launch: note: occupancy query reports %d workgroups per CU\n", per_cu);
        (void)hipGetLastError();
        grid = cus;
    }
    if (grid < 0) return;
    if (hipMemsetAsync((char*)d_ws + WS_CTL + (size_t)CW_BAR * 4, 0, (size_t)(XCD_BAR_WORDS + 16) * 4, stream) != hipSuccess) { fprintf(stderr, "kernel_launch: memset failed\n"); return; }
    Args a{};
    for (int i = 0; i < 9; ++i) a.in[i] = (const float*)d_in[i];
    a.out = (float*)d_out; a.ws = (unsigned char*)d_ws;
    if (N_LAUNCHES == PER_PHASE) {
        for (int li = 0; li < PER_PHASE; ++li) { a.ph_lo = li; a.ph_hi = li + 1; a.li = 0; hipLaunchKernelGGL(hybrid_fwd, dim3(grid), dim3(NWAVES * 64), LDS_BYTES, stream, a); }
    } else {
        a.ph_lo = 0; a.ph_hi = PER_PHASE; a.li = 0;
        hipLaunchKernelGGL(hybrid_fwd, dim3(grid), dim3(NWAVES * 64), LDS_BYTES, stream, a);
    }
    const hipError_t le = hipPeekAtLastError();
    if (le != hipSuccess) fprintf(stderr, "kernel_launch: launch failed: %s\n", hipGetErrorName(le));
}
```
